# Optimizing an MI355X kernel written in HIP

```python
import jax, jax.numpy as jnp
from jax import lax
import numpy as np

D_MODEL = 1024
BATCH = 8
SEQ = 2048
DEPTH = 1
DEC_BATCH = 128
DEC_SEQ = 8
PAST_LEN = 16384
PAGE_SIZE = 128

D_A = D_MODEL // 2
HEAD_DIM = 128
N_HEADS = D_A // HEAD_DIM
D_B = D_MODEL // 2
CONV_W = 3
D_FF = 2816
CHUNK = 32
EPS = 1e-6
SPLIT_POINTS = (D_A, 2 * D_A, 3 * D_A, 4 * D_A, 4 * D_A + D_B, 4 * D_A + 2 * D_B,
                4 * D_A + 3 * D_B, 4 * D_A + 3 * D_B + D_MODEL)
N_IN = 4 * D_A + 3 * D_B + 2 * D_MODEL

kernel_name = "hgrn2_shortconv_gated_macaron_step"


def rmsnorm(x, g):
    xf = x.astype(jnp.float32)
    y = xf * lax.rsqrt(jnp.mean(xf * xf, axis=-1, keepdims=True) + EPS)
    return (y * g.astype(jnp.float32)).astype(x.dtype)


def swiglu(x, w1, w3, w2):
    return (jax.nn.silu(x @ w1) * (x @ w3)) @ w2


def hgrn2_chunked(q, k, v, logf, s0):
    bsz, L, H, dk = q.shape
    dv = v.shape[-1]
    C = CHUNK if L % CHUNK == 0 else L
    N = L // C
    q, k, v, logf = (t.reshape(bsz, N, C, H, t.shape[-1]) for t in (q, k, v, logf))
    b = jnp.cumsum(logf, axis=2)
    b_last = b[:, :, -1:]
    q_d = q * jnp.exp(b)
    k_d = k * jnp.exp(-b)
    scores = jnp.einsum('bnchk,bnshk->bnhcs', q_d, k_d)
    causal = jnp.tril(jnp.ones((C, C), dtype=bool))
    scores = jnp.where(causal, scores, 0.0)
    o_intra = jnp.einsum('bnhcs,bnshv->bnchv', scores, v)
    ds = jnp.einsum('bnchk,bnchv->bnhkv', k * jnp.exp(b_last - b), v)
    decay = jnp.exp(b_last[:, :, 0])

    def step(s, inp):
        dec, d = inp
        return dec[..., None] * s + d, s

    s_final, s_starts = lax.scan(step, s0, (jnp.moveaxis(decay, 1, 0), jnp.moveaxis(ds, 1, 0)))
    s_starts = jnp.moveaxis(s_starts, 0, 1)
    o_inter = jnp.einsum('bnchk,bnhkv->bnchv', q_d, s_starts)
    return (o_intra + o_inter).reshape(bsz, L, H, dv), s_final


def parallel_mixer(h, s_hgrn, s_conv, lb, w_in, conv_w, g_hgrn_out, w_a_out, w_b_out, w_o):
    bsz, L, _ = h.shape
    f32 = jnp.float32
    p = h @ w_in
    q, fz, iv, og, bg, cg, vv, ga, gb = jnp.split(p, SPLIT_POINTS, axis=-1)

    heads = lambda t: t.astype(f32).reshape(bsz, L, N_HEADS, HEAD_DIM)
    z = heads(fz)
    lbh = lb.astype(f32).reshape(N_HEADS, HEAD_DIM)
    f = lbh + (1.0 - lbh) * jax.nn.sigmoid(z)
    k_in = (1.0 - lbh) * jax.nn.sigmoid(-z)
    o, s_hgrn_new = hgrn2_chunked(heads(q), k_in, heads(iv), jnp.log(f), s_hgrn.astype(f32))
    o = o * lax.rsqrt(jnp.mean(o * o, axis=-1, keepdims=True) + EPS)
    o = o * g_hgrn_out.astype(f32).reshape(N_HEADS, HEAD_DIM)
    o = o.reshape(bsz, L, D_A) * jax.nn.silu(og.astype(f32))
    y_a = o.astype(h.dtype) @ w_a_out

    u = cg * vv
    up = jnp.concatenate([s_conv.astype(u.dtype), u], axis=1)
    conv = sum(conv_w[j] * up[:, j:j + L] for j in range(CONV_W))
    y_b = (bg * conv) @ w_b_out
    s_conv_new = up[:, L:]

    merged = jax.nn.sigmoid(ga) * y_a + jax.nn.sigmoid(gb) * y_b
    return merged @ w_o, s_hgrn_new.astype(s_hgrn.dtype), s_conv_new.astype(s_conv.dtype)


def trunk(x, st_h, st_c, lower_bound_logits, g_ffn1, w1_ffn1, w3_ffn1, w2_ffn1, g_mix, w_in,
          conv_w, g_hgrn_out, w_a_out, w_b_out, w_o, g_ffn2, w1_ffn2, w3_ffn2, w2_ffn2, g_final):
    lb_all = jnp.cumsum(jax.nn.softmax(lower_bound_logits.astype(jnp.float32), axis=0), axis=0)
    new_h, new_c = [], []
    for l in range(DEPTH):
        x = x + 0.5 * swiglu(rmsnorm(x, g_ffn1[l]), w1_ffn1[l], w3_ffn1[l], w2_ffn1[l])
        mix, sh, sc = parallel_mixer(rmsnorm(x, g_mix[l]), st_h[l], st_c[l], lb_all[l], w_in[l],
                                     conv_w[l], g_hgrn_out[l], w_a_out[l], w_b_out[l], w_o[l])
        x = x + mix
        x = x + 0.5 * swiglu(rmsnorm(x, g_ffn2[l]), w1_ffn2[l], w3_ffn2[l], w2_ffn2[l])
        new_h.append(sh)
        new_c.append(sc)
    return rmsnorm(x, g_final), jnp.stack(new_h), jnp.stack(new_c)


def setup_inputs(seed: int = 0) -> dict:
    key = jax.random.key(seed)
    ks = jax.random.split(key, 32)
    nrm = lambda k, shape, scale: jax.random.normal(k, shape, jnp.float32) * scale
    gain = lambda k, shape: 1.0 + 0.02 * jax.random.normal(k, shape, jnp.float32)
    return {
        "x_prompt": nrm(ks[0], (BATCH, SEQ, D_MODEL), 1.0),
        "x_sample": nrm(ks[1], (DEC_BATCH, DEC_SEQ, D_MODEL), 1.0),
        "state_hgrn": nrm(ks[2], (DEPTH, DEC_BATCH, N_HEADS, HEAD_DIM, HEAD_DIM), 0.5),
        "state_conv": nrm(ks[3], (DEPTH, DEC_BATCH, CONV_W - 1, D_B), 1.0),
        "lower_bound_logits": nrm(ks[4], (DEPTH + 1, D_A), 0.1),
        "g_ffn1": gain(ks[5], (DEPTH, D_MODEL)),
        "w1_ffn1": nrm(ks[6], (DEPTH, D_MODEL, D_FF), D_MODEL ** -0.5),
        "w3_ffn1": nrm(ks[7], (DEPTH, D_MODEL, D_FF), D_MODEL ** -0.5),
        "w2_ffn1": nrm(ks[8], (DEPTH, D_FF, D_MODEL), D_FF ** -0.5),
        "g_mix": gain(ks[9], (DEPTH, D_MODEL)),
        "w_in": nrm(ks[10], (DEPTH, D_MODEL, N_IN), D_MODEL ** -0.5),
        "conv_w": nrm(ks[11], (DEPTH, CONV_W, D_B), CONV_W ** -0.5),
        "g_hgrn_out": gain(ks[12], (DEPTH, D_A)),
        "w_a_out": nrm(ks[13], (DEPTH, D_A, D_MODEL), D_A ** -0.5),
        "w_b_out": nrm(ks[14], (DEPTH, D_B, D_MODEL), D_B ** -0.5),
        "w_o": nrm(ks[15], (DEPTH, D_MODEL, D_MODEL), D_MODEL ** -0.5),
        "g_ffn2": gain(ks[16], (DEPTH, D_MODEL)),
        "w1_ffn2": nrm(ks[17], (DEPTH, D_MODEL, D_FF), D_MODEL ** -0.5),
        "w3_ffn2": nrm(ks[18], (DEPTH, D_MODEL, D_FF), D_MODEL ** -0.5),
        "w2_ffn2": nrm(ks[19], (DEPTH, D_FF, D_MODEL), D_FF ** -0.5),
        "g_final": gain(ks[20], (D_MODEL,)),
    }


def reference(x_prompt, x_sample, state_hgrn, state_conv, lower_bound_logits, g_ffn1, w1_ffn1,
              w3_ffn1, w2_ffn1, g_mix, w_in, conv_w, g_hgrn_out, w_a_out, w_b_out, w_o, g_ffn2,
              w1_ffn2, w3_ffn2, w2_ffn2, g_final):
    weights = (lower_bound_logits, g_ffn1, w1_ffn1, w3_ffn1, w2_ffn1, g_mix, w_in, conv_w,
               g_hgrn_out, w_a_out, w_b_out, w_o, g_ffn2, w1_ffn2, w3_ffn2, w2_ffn2, g_final)
    n_prompt = x_prompt.shape[0]
    zero_h = jnp.zeros((DEPTH, n_prompt) + state_hgrn.shape[2:], state_hgrn.dtype)
    zero_c = jnp.zeros((DEPTH, n_prompt) + state_conv.shape[2:], state_conv.dtype)
    y_prompt, state_hgrn_prompt, state_conv_prompt = trunk(x_prompt, zero_h, zero_c, *weights)
    y_sample, state_hgrn_sample, state_conv_sample = trunk(x_sample, state_hgrn, state_conv, *weights)
    return (y_prompt, y_sample, state_hgrn_prompt, state_conv_prompt, state_hgrn_sample, state_conv_sample)
```

```cpp
#include <hip/hip_runtime.h>
#include <cstdio>
#include <cstdint>
namespace pg8 {
#define PG8_LAS __attribute__((address_space(3)))
typedef unsigned short bf16_t;
typedef short bf16x8 __attribute__((ext_vector_type(8)));
typedef float f32x4 __attribute__((ext_vector_type(4)));
typedef unsigned u32x4 __attribute__((ext_vector_type(4)));
constexpr int BM = 256, BK = 64, HALF = 128, HTB = HALF * BK * 2  , STAGE_BYTES = 8 * HTB, NXCD = 8, WGM = 8;

__host__ __device__ __forceinline__ int lds_byte(int r, int c) { const int st = (r >> 4) * 2 + (c >> 5), rr = r & 15, cc = c & 31, ob = rr * 64 + cc * 2; return st * 1024 + (ob ^ (((ob >> 9) & 1) << 5)); }
__host__ __device__ __forceinline__ void stage_rc(int b, int& R, int& C) { const int st = b / 1024, sb = b % 1024, swz = sb ^ (((sb >> 9) & 1) << 5); R = (st >> 1) * 16 + swz / 64; C = (st & 1) * 32 + (swz % 64) / 2; }
__host__ __device__ __forceinline__ int perm32(int rho) { const int n = rho >> 4, i = rho & 15; return 8 * (i >> 2) + 4 * n + (i & 3); }

struct Unit { int pm, pn; };
struct Gemm { const bf16_t* A; const bf16_t* Bt; int M, N, K; };

struct StaticOrder {
    int nM, nN, nwg, G, c;
    __host__ __device__ void init(int M, int N, int G_, int c_) { nM = M / BM; nN = N / BM; nwg = nM * nN; G = G_; c = c_; }
    __host__ __device__ bool next(int i, Unit& u) const {
        const long L = (long)i * G + c; if (L >= nwg) return false;
        int wgid = (int)L; { const int q = nwg / NXCD, r = nwg % NXCD, xcd = wgid % NXCD, off = wgid / NXCD; wgid = (xcd < r ? xcd * (q + 1) : r * (q + 1) + (xcd - r) * q) + off; }
        const int nig = WGM * nN, gid = wgid / nig, fm = gid * WGM, gsz = (nM - fm) < WGM ? (nM - fm) : WGM;
        u.pm = fm + ((wgid % nig) % gsz); u.pn = (wgid % nig) / gsz; return true;
    }
    __device__ __forceinline__ void a_ready(const Unit&) const {}
    __device__ __forceinline__ void done(const Unit&) const {}
};

__device__ __forceinline__ unsigned cvt_pk_bf16(float lo, float hi) { unsigned r; asm volatile("v_cvt_pk_bf16_f32 %0, %1, %2" : "=v"(r) : "v"(lo), "v"(hi)); return r; }

template <class Epi, class Sched, bool ALIGN_EPI = false, bool SP2 = false>
__device__ __forceinline__ void gemm_phase(PG8_LAS unsigned char* lds, const Gemm g, const Sched& S, const Epi& E) {
    const int tid = threadIdx.x, wid = __builtin_amdgcn_readfirstlane(tid >> 6), lane = tid & 63, wr = wid >> 2, wc = wid & 3, fr = lane & 15, fq = lane >> 4;
    const int K = g.K, nt = K / BK;
    unsigned voffA[2], voffB[2];
#pragma unroll
    for (int i = 0; i < 2; ++i) { int R, C; stage_rc(tid * 16 + i * 8192, R, C); const int Rb = Epi::PERM ? ((R & ~31) + perm32(R & 31)) : R;
        voffA[i] = (unsigned)(R * K + C) * 2u; voffB[i] = (unsigned)(Rb * K + C) * 2u; }
    const size_t kstep = (size_t)(BK * 2);
    const size_t hstep = (size_t)HALF * K * 2;
    const size_t tstep = 2 * hstep;
    const unsigned ldsw = (unsigned)wid * 1024u;
    const int aoff = lds_byte(wr * 64 + fr, fq * 8), boff = lds_byte(wc * 32 + fr, fq * 8);
#define PG8_SA(b, h) (((b) * 2 + (h)) * HTB)
#define PG8_SB(b, h) ((4 + (b) * 2 + (h)) * HTB)
#define PG8_STAGE(bufoff, gbase, voff) do { _Pragma("unroll") for (int _i = 0; _i < 2; ++_i) \
        __builtin_amdgcn_global_load_lds((const unsigned*)((const char*)(gbase) + (voff)[_i]), (PG8_LAS unsigned*)(lds + (bufoff) + ldsw + _i * 8192), 16, 0, 0); } while (0)
#define PG8_LDA(dst, b, h) do { _Pragma("unroll") for (int m = 0; m < 4; ++m) _Pragma("unroll") for (int k = 0; k < 2; ++k) dst[m][k] = *(const PG8_LAS bf16x8*)(lds + PG8_SA(b, h) + aoff + m * 2048 + k * 1024); } while (0)
#define PG8_LDB(dst, b, h) do { _Pragma("unroll") for (int n = 0; n < 2; ++n) _Pragma("unroll") for (int k = 0; k < 2; ++k) dst[n][k] = *(const PG8_LAS bf16x8*)(lds + PG8_SB(b, h) + boff + n * 2048 + k * 1024); } while (0)
#define PG8_MMA(ai, bj, At, Bt) do { __builtin_amdgcn_s_setprio(1); _Pragma("unroll") for (int m = 0; m < 4; ++m) _Pragma("unroll") for (int n = 0; n < 2; ++n) _Pragma("unroll") for (int k = 0; k < 2; ++k) \
        acc[ai][bj][m][n] = __builtin_amdgcn_mfma_f32_16x16x32_bf16(Bt[n][k], At[m][k], acc[ai][bj][m][n], 0, 0, 0); __builtin_amdgcn_s_setprio(0); } while (0)
#define PG8_WAIT_V(n) asm volatile("s_waitcnt vmcnt(" #n ")" ::: "memory")
#define PG8_WAIT_L(n) asm volatile("s_waitcnt lgkmcnt(" #n ")" ::: "memory")
#define PG8_BAR __builtin_amdgcn_s_barrier()
#define PG8_SCHED __builtin_amdgcn_sched_barrier(0)
    Unit cur, nxt; int ui = 0;
    if (!S.next(0, cur)) return;
    f32x4 acc[2][2][4][2];
#pragma unroll
    for (int a = 0; a < 2; ++a)
#pragma unroll
        for (int b = 0; b < 2; ++b)
#pragma unroll
            for (int m = 0; m < 4; ++m)
#pragma unroll
                for (int n = 0; n < 2; ++n) acc[a][b][m][n] = (f32x4){0.f, 0.f, 0.f, 0.f};
    bf16x8 At[4][2], B0[2][2], B1[2][2];
    const char* cA = (const char*)g.A + (size_t)cur.pm * tstep; const char* cB = (const char*)g.Bt + (size_t)cur.pn * tstep;
    S.a_ready(cur);
    if constexpr (SP2) {
        PG8_STAGE(PG8_SB(0, 0), cB, voffB); PG8_STAGE(PG8_SB(0, 1), cB + hstep, voffB); PG8_STAGE(PG8_SA(0, 0), cA, voffA); PG8_STAGE(PG8_SA(0, 1), cA + hstep, voffA);
        if (wr == 1) PG8_BAR;
        PG8_WAIT_V(2); PG8_BAR;
        PG8_STAGE(PG8_SB(1, 0), cB + kstep, voffB); PG8_STAGE(PG8_SA(1, 0), cA + kstep, voffA); PG8_STAGE(PG8_SB(1, 1), cB + hstep + kstep, voffB);
        PG8_WAIT_V(6); PG8_BAR;
    } else {
        PG8_STAGE(PG8_SB(0, 0), cB, voffB); PG8_STAGE(PG8_SA(0, 0), cA, voffA); PG8_STAGE(PG8_SB(0, 1), cB + hstep, voffB); PG8_STAGE(PG8_SA(0, 1), cA + hstep, voffA);
        if (wr == 1) PG8_BAR;
        PG8_WAIT_V(4); PG8_BAR;
        PG8_STAGE(PG8_SB(1, 0), cB + kstep, voffB); PG8_STAGE(PG8_SA(1, 0), cA + kstep, voffA); PG8_STAGE(PG8_SB(1, 1), cB + hstep + kstep, voffB);
        PG8_WAIT_V(6); PG8_BAR;
    }
    for (;;) {
        const bool has_next = S.next(ui + 1, nxt);
        const char* nA = has_next ? (const char*)g.A + (size_t)nxt.pm * tstep : cA; const char* nB = has_next ? (const char*)g.Bt + (size_t)nxt.pn * tstep : cB;
        for (int t = 0; t < nt; t += 2) {
            const bool last = (t == nt - 2);
            const char* a1 = cA + (size_t)(t + 1) * kstep;
            const char* a2 = last ? nA : cA + (size_t)(t + 2) * kstep; const char* b2 = last ? nB : cB + (size_t)(t + 2) * kstep;
            const char* a3 = a2 + kstep; const char* b3 = b2 + kstep;
            if (last && has_next) S.a_ready(nxt);
            if constexpr (SP2) {
            PG8_LDB(B0, 0, 0); PG8_LDB(B1, 0, 1); PG8_SCHED; PG8_LDA(At, 0, 0); PG8_STAGE(PG8_SA(1, 1), a1 + hstep, voffA);
            PG8_WAIT_V(8); PG8_WAIT_L(0); PG8_BAR; PG8_MMA(0, 0, At, B0); PG8_MMA(0, 1, At, B1); PG8_BAR; PG8_SCHED;
            PG8_LDA(At, 0, 1); PG8_STAGE(PG8_SB(0, 0), b2, voffB); PG8_STAGE(PG8_SB(0, 1), b2 + hstep, voffB); PG8_STAGE(PG8_SA(0, 0), a2, voffA);
            PG8_WAIT_V(8); PG8_WAIT_L(0); PG8_BAR; PG8_MMA(1, 0, At, B0); PG8_MMA(1, 1, At, B1); PG8_BAR; PG8_SCHED;
            PG8_LDB(B0, 1, 0); PG8_LDB(B1, 1, 1); PG8_SCHED; PG8_LDA(At, 1, 0); PG8_STAGE(PG8_SA(0, 1), a2 + hstep, voffA);
            PG8_WAIT_V(8); PG8_WAIT_L(0); PG8_BAR; PG8_MMA(0, 0, At, B0); PG8_MMA(0, 1, At, B1); PG8_BAR; PG8_SCHED;
            PG8_LDA(At, 1, 1); PG8_STAGE(PG8_SB(1, 0), b3, voffB); PG8_STAGE(PG8_SB(1, 1), b3 + hstep, voffB); PG8_STAGE(PG8_SA(1, 0), a3, voffA);
            PG8_WAIT_V(8); PG8_WAIT_L(0); PG8_BAR; PG8_MMA(1, 0, At, B0); PG8_MMA(1, 1, At, B1); PG8_BAR; PG8_SCHED;
            } else {
            PG8_LDB(B0, 0, 0); PG8_SCHED; PG8_LDA(At, 0, 0); PG8_STAGE(PG8_SA(1, 1), a1 + hstep, voffA);
            PG8_WAIT_L(8); PG8_BAR; PG8_WAIT_L(0); PG8_MMA(0, 0, At, B0); PG8_BAR; PG8_SCHED;
            PG8_LDB(B1, 0, 1); PG8_STAGE(PG8_SB(0, 0), b2, voffB);
            PG8_BAR; PG8_WAIT_L(0); PG8_MMA(0, 1, At, B1); PG8_BAR;
            PG8_LDA(At, 0, 1); PG8_STAGE(PG8_SA(0, 0), a2, voffA);
            PG8_BAR; PG8_WAIT_L(0); PG8_MMA(1, 0, At, B0); PG8_BAR; PG8_SCHED;
            PG8_STAGE(PG8_SB(0, 1), b2 + hstep, voffB);
            PG8_WAIT_V(6); PG8_BAR; PG8_MMA(1, 1, At, B1); PG8_BAR;
            PG8_LDB(B0, 1, 0); PG8_SCHED; PG8_LDA(At, 1, 0); PG8_STAGE(PG8_SA(0, 1), a2 + hstep, voffA);
            PG8_WAIT_L(8); PG8_BAR; PG8_WAIT_L(0); PG8_MMA(0, 0, At, B0); PG8_BAR; PG8_SCHED;
            PG8_LDB(B1, 1, 1); PG8_STAGE(PG8_SB(1, 0), b3, voffB);
            PG8_BAR; PG8_WAIT_L(0); PG8_MMA(0, 1, At, B1); PG8_BAR;
            PG8_LDA(At, 1, 1); PG8_STAGE(PG8_SA(1, 0), a3, voffA);
            PG8_BAR; PG8_WAIT_L(0); PG8_MMA(1, 0, At, B0); PG8_BAR; PG8_SCHED;
            PG8_STAGE(PG8_SB(1, 1), b3 + hstep, voffB);
            PG8_WAIT_V(6); PG8_BAR; PG8_MMA(1, 1, At, B1); PG8_BAR;
            }
        }
        if constexpr (ALIGN_EPI) { if (wr == 0) PG8_BAR; }
        if constexpr (!Epi::AFTER_DRAIN) { E(acc, cur, wr, wc, fr, fq); S.done(cur); }
        if (!has_next) break;
#pragma unroll
        for (int a = 0; a < 2; ++a)
#pragma unroll
            for (int b = 0; b < 2; ++b)
#pragma unroll
                for (int m = 0; m < 4; ++m)
#pragma unroll
                    for (int n = 0; n < 2; ++n) acc[a][b][m][n] = (f32x4){0.f, 0.f, 0.f, 0.f};
        cur = nxt; cA = nA; cB = nB; ++ui;
        if constexpr (ALIGN_EPI) { if (wr == 1) PG8_BAR; }
    }
    PG8_WAIT_V(0);
    if constexpr (!ALIGN_EPI) { if (wr == 0) PG8_BAR; }
    PG8_BAR;
    if constexpr (Epi::AFTER_DRAIN) { E.fused(acc, cur, wr, wc, fr, fq, lds, wid, lane); S.done(cur); }
#undef PG8_SA
#undef PG8_SB
#undef PG8_STAGE
#undef PG8_LDA
#undef PG8_LDB
#undef PG8_MMA
#undef PG8_WAIT_V
#undef PG8_WAIT_L
#undef PG8_BAR
#undef PG8_SCHED
}
}

constexpr int DM = 1024, DFF = 2816, DA = 512, NIN = 5632;
constexpr int TP = 16384, TS = 1024, T = TP + TS;
constexpr int NSEQ_P = 32, NSEQ_S = 512;
constexpr float EPS = 1e-6f;
constexpr int NWAVES = 8;

constexpr size_t OUT_Y = 0, OUT_SHP = (size_t)T * DM, OUT_SCP = OUT_SHP + 524288, OUT_SHS = OUT_SCP + 8192, OUT_SCS = OUT_SHS + 8388608, OUT_END = OUT_SCS + 131072;

constexpr size_t MiB = 1u << 20;
constexpr size_t WS_CTL = 0, CTL_ZERO_BYTES = 1 * MiB;
constexpr size_t WS_WIN = 1 * MiB, WS_WA = 12 * MiB, WS_WB = 13 * MiB, WS_WO = 14 * MiB;
constexpr size_t WS_W13 = 16 * MiB, WS_W2 = 27 * MiB;
constexpr size_t WS_XN = 32 * MiB + 512 * 1024;
constexpr size_t WS_ARENA = WS_XN + 34 * MiB;
constexpr size_t UNITB = (size_t)T * 512 * 2;
constexpr size_t WS_H = WS_ARENA;
constexpr size_t WS_SGA = WS_ARENA, WS_SGB = WS_ARENA + 2 * UNITB, WS_OG = WS_ARENA + 4 * UNITB, WS_BG = WS_ARENA + 5 * UNITB, WS_U = WS_ARENA + 6 * UNITB;
constexpr size_t WS_Q = WS_ARENA + 7 * UNITB, WS_V = WS_ARENA + 8 * UNITB, WS_LOGF = WS_ARENA + 9 * UNITB;
constexpr size_t WS_ZA = WS_Q, WS_ZB = WS_V, WS_MG = WS_LOGF;
constexpr size_t WS_PARTP = WS_ARENA + 11 * UNITB;
constexpr size_t WS_PARTS = WS_PARTP + (size_t)TP * 16;
constexpr size_t WS_END = WS_PARTS + (size_t)TS * 64;
static_assert(WS_END <= 256 * MiB, "ws map");
static_assert((size_t)T * DFF * 2 <= 6 * UNITB, "H fits");
constexpr int CW_BAR = 4096;

constexpr int RING_BYTES = 131072, LDSCTL_OFF = RING_BYTES, MISC_OFF = LDSCTL_OFF + 320, ROWSUM_OFF = RING_BYTES + 2048, PMT_OFF = RING_BYTES + 3072, RSL_OFF = RING_BYTES + 4096, RSL_SLOTS = 6, LDS_BYTES = 147456;

#define GAS __attribute__((address_space(1)))
#define LAS __attribute__((address_space(3)))
typedef unsigned short bf16;
typedef unsigned v4u __attribute__((ext_vector_type(4)));
typedef unsigned v2u __attribute__((ext_vector_type(2)));
typedef float f32x4 __attribute__((ext_vector_type(4)));
typedef short bf16x8 __attribute__((ext_vector_type(8)));
typedef GAS unsigned gu32;
#define NTL(p) (*(p))
#define LDS_WAIT() asm volatile("s_waitcnt lgkmcnt(0)" ::: "memory")
#define VM_WAIT() asm volatile("s_waitcnt vmcnt(0)" ::: "memory")
#define LDSBAR() do { asm volatile("s_waitcnt lgkmcnt(0)" ::: "memory"); __builtin_amdgcn_s_barrier(); asm volatile("" ::: "memory"); } while (0)
__device__ __forceinline__ unsigned f2bf(float f) { unsigned u = __builtin_bit_cast(unsigned, f); return (u + 0x7fffu + ((u >> 16) & 1u)) >> 16; }
typedef float f32x2_t_ __attribute__((ext_vector_type(2)));
typedef __bf16 bf16x2_t_ __attribute__((ext_vector_type(2)));
__device__ __forceinline__ unsigned pk2(float lo, float hi) { const f32x2_t_ v = {lo, hi}; return __builtin_bit_cast(unsigned, __builtin_convertvector(v, bf16x2_t_)); }
__device__ __forceinline__ float bf2f(unsigned short h) { return __builtin_bit_cast(float, (unsigned)h << 16); }
__device__ __forceinline__ float bflo(unsigned w) { return __builtin_bit_cast(float, w << 16); }
__device__ __forceinline__ float bfhi(unsigned w) { return __builtin_bit_cast(float, w & 0xffff0000u); }
__device__ __forceinline__ float sigmoidf_(float x) { return __builtin_amdgcn_rcpf(1.0f + __expf(-x)); }
__device__ __forceinline__ float siluf_(float x) { return x * sigmoidf_(x); }

#define XB_TMO      128
#define XB_XCNT(j)  (256  + 64 * (j))
#define XB_XSUB(j)  (1280 + 64 * (j))
#define XB_XGEN(j)  (2304 + 64 * (j))
#define XB_TOP      3328
#define XB_TOPGEN   3392
#define XCD_BAR_WORDS 3456
#define XB_SPIN_CAP (1u << 18)

__device__ __forceinline__ unsigned xb_ld(unsigned* p)              { return __hip_atomic_load(p, __ATOMIC_RELAXED, __HIP_MEMORY_SCOPE_AGENT); }
__device__ __forceinline__ unsigned xb_add(unsigned* p, unsigned v) { return __hip_atomic_fetch_add(p, v, __ATOMIC_RELAXED, __HIP_MEMORY_SCOPE_AGENT); }
__device__ __forceinline__ unsigned xb_xcc_id() { return (unsigned)__builtin_amdgcn_s_getreg((3 << 11) | 20) & 0xFu; }
#define XB_SPIN(cond, bar) do { unsigned _sp = 0; while (cond) { __builtin_amdgcn_s_sleep(1); \
    if ((++_sp & 255u) == 0u) { if (xb_ld(&(bar)[XB_TMO])) break; if (_sp > XB_SPIN_CAP) { atomicAdd(&(bar)[XB_TMO], 1u); break; } } } } while (0)

struct XcdBarrier {
    unsigned* bar; unsigned x;
    volatile LAS unsigned* st;
};

__device__ __forceinline__ XcdBarrier xcd_barrier_post(unsigned* bar, volatile LAS unsigned* st) {
    XcdBarrier b; b.bar = bar; b.x = xb_xcc_id(); b.st = st;
    if (threadIdx.x == 0) (void)xb_add(&bar[XB_XCNT(b.x)], 1u);
    return b;
}
__device__ __forceinline__ void xcd_barrier_complete(unsigned* bar, unsigned x, unsigned& nloc, unsigned& nx) {
    const unsigned G = gridDim.x * gridDim.y * gridDim.z;
    unsigned sum, cnt, mine, sp = 0u;
    for (;;) {
        sum = 0u; cnt = 0u; mine = 0u;
#pragma unroll
        for (unsigned j = 0; j < 16; ++j) { const unsigned c = xb_ld(&bar[XB_XCNT(j)]); sum += c; cnt += (c > 0u) ? 1u : 0u; mine = (j == x) ? c : mine; }
        if (sum == G) break;
        __builtin_amdgcn_s_sleep(1);
        if ((++sp & 255u) == 0u) { if (xb_ld(&bar[XB_TMO])) break; if (sp > XB_SPIN_CAP) { atomicAdd(&bar[XB_TMO], 1u); break; } }
    }
    nloc = mine > 0u ? mine : 1u; nx = cnt > 0u ? cnt : 1u;
}

__device__ __forceinline__ void xcd_barrier(const XcdBarrier& b) {
    asm volatile("s_waitcnt vmcnt(0)" ::: "memory");
    __syncthreads();
    if (threadIdx.x == 0) {
        unsigned* bar = b.bar;
        __builtin_amdgcn_s_waitcnt(0);
        unsigned nloc = b.st[0], nx = b.st[1];
        if (nloc == 0u) { xcd_barrier_complete(bar, b.x, nloc, nx); b.st[0] = nloc; b.st[1] = nx; }
        const unsigned old = xb_add(&bar[XB_XSUB(b.x)], 1u);
        const unsigned gen = old / nloc;
        if (old + 1u == (gen + 1u) * nloc) {
            __builtin_amdgcn_fence(__ATOMIC_RELEASE, "agent");
            asm volatile("s_waitcnt vmcnt(0)" ::: "memory");
            const unsigned og = xb_add(&bar[XB_TOP], 1u);
            const unsigned tg = og / nx;
            if (og + 1u == (tg + 1u) * nx) xb_add(&bar[XB_TOPGEN], 1u);
            else XB_SPIN(xb_ld(&bar[XB_TOPGEN]) == tg, bar);
            __builtin_amdgcn_fence(__ATOMIC_ACQUIRE, "agent");
            xb_add(&bar[XB_XGEN(b.x)], 1u);
            asm volatile("s_waitcnt vmcnt(0)" ::: "memory");
        } else {
            XB_SPIN(xb_ld(&bar[XB_XGEN(b.x)]) == gen, bar);
            __builtin_amdgcn_fence(__ATOMIC_ACQUIRE, "agent");
            asm volatile("s_waitcnt vmcnt(0)" ::: "memory");
        }
    }
    __syncthreads();
}


#if defined(PROBE_E2) || defined(PROBE_E3) || defined(PROBE_E4) || defined(PROBE_E5)
__device__ __forceinline__ void xcd_barrier_probe(const XcdBarrier& b) {
    asm volatile("s_waitcnt vmcnt(0)" ::: "memory");
    __syncthreads();
    if (threadIdx.x == 0) {
        unsigned* bar = b.bar;
        unsigned nloc = b.st[0], nx = b.st[1];
        const unsigned old = xb_add(&bar[XB_XSUB(b.x)], 1u);
        const unsigned gen = old / nloc;
        if (old + 1u == (gen + 1u) * nloc) {
#if !defined(PROBE_E3) && !defined(PROBE_E4)
            __builtin_amdgcn_fence(__ATOMIC_RELEASE, "agent");
#endif
            asm volatile("s_waitcnt vmcnt(0)" ::: "memory");
            const unsigned og = xb_add(&bar[XB_TOP], 1u);
            const unsigned tg = og / nx;
            if (og + 1u == (tg + 1u) * nx) xb_add(&bar[XB_TOPGEN], 1u);
            else XB_SPIN(xb_ld(&bar[XB_TOPGEN]) == tg, bar);
#if !defined(PROBE_E2) && !defined(PROBE_E4)
            __builtin_amdgcn_fence(__ATOMIC_ACQUIRE, "agent");
#endif
            xb_add(&bar[XB_XGEN(b.x)], 1u);
            asm volatile("s_waitcnt vmcnt(0)" ::: "memory");
        } else {
            XB_SPIN(xb_ld(&bar[XB_XGEN(b.x)]) == gen, bar);
#if !defined(PROBE_E2) && !defined(PROBE_E4) && !defined(PROBE_E5)
            __builtin_amdgcn_fence(__ATOMIC_ACQUIRE, "agent");
#endif
            asm volatile("s_waitcnt vmcnt(0)" ::: "memory");
        }
    }
    __syncthreads();
}
#endif

namespace pg8 {
static_assert(RSL_OFF + RSL_SLOTS * 1024 <= LDS_BYTES, "rstd slots inside the LDS allocation");
__device__ __forceinline__ float row_rstd(const float* PP, const float* PS, int row) {
    float ss;
    if (row < TP) { const f32x4 a = NTL((const f32x4*)(PP + (size_t)row * 4)); ss = (a[0] + a[1]) + (a[2] + a[3]); }
    else { const f32x4* p = (const f32x4*)(PS + (size_t)(row - TP) * 16); const f32x4 a = (NTL(p) + NTL(p + 1)) + (NTL(p + 2) + NTL(p + 3)); ss = (a[0] + a[1]) + (a[2] + a[3]); }
    return 1.0f / sqrtf(ss * (1.0f / DM) + EPS);
}
__device__ __forceinline__ int rstd_slot(PG8_LAS unsigned char* ldsb, int pm) {
    const PG8_LAS int* PMT = (const PG8_LAS int*)(ldsb + PMT_OFF); int slot = -1;
#pragma unroll
    for (int i = 0; i < RSL_SLOTS; ++i) if (PMT[i] == pm) slot = i;
    return slot;
}
struct EpiSwiglu {
    static constexpr bool PERM = false, AFTER_DRAIN = false;
    bf16_t* H; int ldh; const float* PP; const float* PS; PG8_LAS unsigned char* ldsb;
    __device__ __forceinline__ void operator()(const f32x4 (&acc)[2][2][4][2], const Unit& u, int wr, int wc, int fr, int fq) const {
        const int row0 = u.pm * BM + wr * 64 + fr, hid0 = u.pn * 128 + wc * 16 + 4 * fq;
        float rs[2][4];
#pragma unroll
        for (int ai = 0; ai < 2; ++ai)
#pragma unroll
            for (int m = 0; m < 4; ++m) rs[ai][m] = 1.0f;
        if (PP) { const int slot = rstd_slot(ldsb, u.pm); const PG8_LAS float* RSL = (const PG8_LAS float*)(ldsb + RSL_OFF) + (slot < 0 ? 0 : slot) * 256 + wr * 64 + fr;
#pragma unroll
            for (int ai = 0; ai < 2; ++ai)
#pragma unroll
                for (int m = 0; m < 4; ++m) rs[ai][m] = slot >= 0 ? RSL[ai * HALF + m * 16] : row_rstd(PP, PS, row0 + ai * HALF + m * 16); }
#pragma unroll
        for (int ai = 0; ai < 2; ++ai)
#pragma unroll
            for (int m = 0; m < 4; ++m) { bf16_t* rowp = H + (size_t)(row0 + ai * HALF + m * 16) * ldh + hid0;
#pragma unroll
                for (int bj = 0; bj < 2; ++bj) { const f32x4 a = acc[ai][bj][m][0] * rs[ai][m], b = acc[ai][bj][m][1] * rs[ai][m];
                    v2u w; w.x = pk2(siluf_(a[0]) * b[0], siluf_(a[1]) * b[1]); w.y = pk2(siluf_(a[2]) * b[2], siluf_(a[3]) * b[3]);
                    *(v2u*)(rowp + bj * 64) = w; } }
    }
};
template <bool HALF_ALPHA> struct EpiRes {
    static constexpr bool PERM = false, AFTER_DRAIN = false;
    static constexpr float alpha = HALF_ALPHA ? 0.5f : 1.0f;
    const float* srcP; const float* srcS; float* out; bf16_t* XNo; float* PP; float* PS; PG8_LAS unsigned char* ldsb; const float* gain;
    __device__ __forceinline__ bool has_norm() const { return XNo != nullptr; }
    __device__ __forceinline__ float store4(int row, int col, f32x4 a) const {
        const float* sb = (row < TP) ? srcP : srcS - (size_t)TP * DM; const size_t o = (size_t)row * DM + col;
        const f32x4 s = NTL((const f32x4*)(sb + o)); const f32x4 v = s + a * alpha; *(f32x4*)(out + o) = v;
        if (XNo) { const f32x4 gg = *(const f32x4*)(gain + col); v2u w; w.x = pk2(v[0] * gg[0], v[1] * gg[1]); w.y = pk2(v[2] * gg[2], v[3] * gg[3]); *(v2u*)(XNo + o) = w; return (v[0] * v[0] + v[1] * v[1]) + (v[2] * v[2] + v[3] * v[3]); }
        return 0.f;
    }
    __device__ __forceinline__ void row_store_s(int row, int slot, float ss) const { PS[(size_t)(row - TP) * 16 + slot] = ss; }
    struct Pre { f32x4 s; };
    __device__ __forceinline__ Pre pre4(int row, int col) const { const float* sb = (row < TP) ? srcP : srcS - (size_t)TP * DM; Pre p; p.s = NTL((const f32x4*)(sb + (size_t)row * DM + col)); return p; }
    __device__ __forceinline__ float store4pg(int row, int col, f32x4 a, const Pre& p, f32x4 gg) const {
        const size_t o = (size_t)row * DM + col; const f32x4 v = p.s + a * alpha; *(f32x4*)(out + o) = v;
        if (XNo) { v2u w; w.x = pk2(v[0] * gg[0], v[1] * gg[1]); w.y = pk2(v[2] * gg[2], v[3] * gg[3]); *(v2u*)(XNo + o) = w; return (v[0] * v[0] + v[1] * v[1]) + (v[2] * v[2] + v[3] * v[3]); }
        return 0.f;
    }
    __device__ __forceinline__ float store4p(int row, int col, f32x4 a, const Pre& p) const {
        const size_t o = (size_t)row * DM + col; const f32x4 v = p.s + a * alpha; *(f32x4*)(out + o) = v;
        if (XNo) { const f32x4 gg = *(const f32x4*)(gain + col); v2u w; w.x = pk2(v[0] * gg[0], v[1] * gg[1]); w.y = pk2(v[2] * gg[2], v[3] * gg[3]); *(v2u*)(XNo + o) = w; return (v[0] * v[0] + v[1] * v[1]) + (v[2] * v[2] + v[3] * v[3]); }
        return 0.f;
    }
    __device__ __forceinline__ void operator()(const f32x4 (&acc)[2][2][4][2], const Unit& u, int wr, int wc, int fr, int fq) const {
        const int row0 = u.pm * BM + wr * 64 + fr, col0 = u.pn * BM + wc * 32 + 4 * fq;
        PG8_LAS float* ROWSUM = (PG8_LAS float*)(ldsb + ROWSUM_OFF);
        const bool norm = has_norm();
        if (norm) { if (threadIdx.x < 256) ROWSUM[threadIdx.x] = 0.f; asm volatile("s_waitcnt lgkmcnt(0)" ::: "memory"); __builtin_amdgcn_s_barrier(); asm volatile("" ::: "memory"); }
        f32x4 gg[2][2];
#pragma unroll
        for (int bj = 0; bj < 2; ++bj)
#pragma unroll
            for (int n = 0; n < 2; ++n) gg[bj][n] = norm ? *(const f32x4*)(gain + col0 + bj * HALF + n * 16) : (f32x4){0.f, 0.f, 0.f, 0.f};
#pragma unroll
        for (int am = 0; am < 4; ++am) {
            const int ai = am >> 1, mb = (am & 1) * 2;
            Pre pv[2][2][2];
#pragma unroll
            for (int mm = 0; mm < 2; ++mm)
#pragma unroll
                for (int bj = 0; bj < 2; ++bj)
#pragma unroll
                    for (int n = 0; n < 2; ++n) pv[mm][bj][n] = pre4(row0 + ai * HALF + (mb + mm) * 16, col0 + bj * HALF + n * 16);
#pragma unroll
            for (int mm = 0; mm < 2; ++mm) { const int m = mb + mm; float ss = 0.f;
#pragma unroll
                for (int bj = 0; bj < 2; ++bj)
#pragma unroll
                    for (int n = 0; n < 2; ++n) ss += store4pg(row0 + ai * HALF + m * 16, col0 + bj * HALF + n * 16, acc[ai][bj][m][n], pv[mm][bj][n], gg[bj][n]);
                if (norm) { ss += __shfl_xor(ss, 16); ss += __shfl_xor(ss, 32); if (fq == 0) (void)__hip_atomic_fetch_add(ROWSUM + ai * HALF + wr * 64 + m * 16 + fr, ss, __ATOMIC_RELAXED, __HIP_MEMORY_SCOPE_WORKGROUP); } }
        }
        if (norm) { asm volatile("s_waitcnt lgkmcnt(0)" ::: "memory"); __builtin_amdgcn_s_barrier(); asm volatile("" ::: "memory");
            if (threadIdx.x < 256) PP[(size_t)(u.pm * BM + threadIdx.x) * 4 + u.pn] = ROWSUM[threadIdx.x]; }
    }
};
template <int MODE> struct EpiGate {
    static constexpr bool PERM = false, AFTER_DRAIN = false;
    const bf16_t* SG; bf16_t* MG;
    __device__ __forceinline__ bool has_norm() const { return false; }
    __device__ __forceinline__ void row_store_s(int, int, float) const {}
    struct Pre { v2u g, m; };
    __device__ __forceinline__ Pre pre4(int row, int col) const { const size_t o = (size_t)row * DM + col; Pre p; p.g = NTL((const v2u*)(SG + o)); p.m = (v2u){0u, 0u}; if (MODE == 1) p.m = NTL((const v2u*)(MG + o)); return p; }
    __device__ __forceinline__ float store4p(int row, int col, f32x4 a, const Pre& p) const {
        const size_t o = (size_t)row * DM + col;
        float r0 = bflo(p.g.x) * a[0], r1 = bfhi(p.g.x) * a[1], r2 = bflo(p.g.y) * a[2], r3 = bfhi(p.g.y) * a[3];
        if (MODE == 1) { r0 += bflo(p.m.x); r1 += bfhi(p.m.x); r2 += bflo(p.m.y); r3 += bfhi(p.m.y); }
        v2u w; w.x = pk2(r0, r1); w.y = pk2(r2, r3); *(v2u*)(MG + o) = w; return 0.f;
    }
    __device__ __forceinline__ float store4(int row, int col, f32x4 a) const {
        const size_t o = (size_t)row * DM + col; const v2u g = NTL((const v2u*)(SG + o));
        float r0 = bflo(g.x) * a[0], r1 = bfhi(g.x) * a[1], r2 = bflo(g.y) * a[2], r3 = bfhi(g.y) * a[3];
        if (MODE == 1) { const v2u p = NTL((const v2u*)(MG + o)); r0 += bflo(p.x); r1 += bfhi(p.x); r2 += bflo(p.y); r3 += bfhi(p.y); }
        v2u w; w.x = pk2(r0, r1); w.y = pk2(r2, r3); *(v2u*)(MG + o) = w; return 0.f;
    }
    __device__ __forceinline__ void operator()(const f32x4 (&acc)[2][2][4][2], const Unit& u, int wr, int wc, int fr, int fq) const {
        const int row0 = u.pm * BM + wr * 64 + fr, col0 = u.pn * BM + wc * 32 + 4 * fq;
#pragma unroll
        for (int am = 0; am < 4; ++am) {
            const int ai = am >> 1, mb = (am & 1) * 2;
            Pre pv[2][2][2];
#pragma unroll
            for (int mm = 0; mm < 2; ++mm)
#pragma unroll
                for (int bj = 0; bj < 2; ++bj)
#pragma unroll
                    for (int n = 0; n < 2; ++n) pv[mm][bj][n] = pre4(row0 + ai * HALF + (mb + mm) * 16, col0 + bj * HALF + n * 16);
#pragma unroll
            for (int mm = 0; mm < 2; ++mm)
#pragma unroll
                for (int bj = 0; bj < 2; ++bj)
#pragma unroll
                    for (int n = 0; n < 2; ++n) (void)store4p(row0 + ai * HALF + (mb + mm) * 16, col0 + bj * HALF + n * 16, acc[ai][bj][mb + mm][n], pv[mm][bj][n]);
        }
    }
};
struct EpiMix {
    static constexpr bool PERM = false, AFTER_DRAIN = false;
    bf16_t *Q, *V, *OG, *BG, *U, *SGA, *SGB; float* LOGF; const float* lbl; const float* PP; const float* PS; PG8_LAS unsigned char* ldsb;
    __device__ __forceinline__ void operator()(const f32x4 (&acc_)[2][2][4][2], const Unit& u, int wr, int wc, int fr, int fq) const {
        const int pn = u.pn, row0 = u.pm * BM + wr * 64 + fr;
        f32x4 acc[2][2][4][2];
        { float rs[2][4]; const int slot_ = rstd_slot(ldsb, u.pm); const PG8_LAS float* RSL_ = (const PG8_LAS float*)(ldsb + RSL_OFF) + (slot_ < 0 ? 0 : slot_) * 256 + wr * 64 + fr;
#pragma unroll
          for (int ai = 0; ai < 2; ++ai)
#pragma unroll
              for (int m = 0; m < 4; ++m) { rs[ai][m] = slot_ >= 0 ? RSL_[ai * HALF + m * 16] : row_rstd(PP, PS, row0 + ai * HALF + m * 16); }
#pragma unroll
          for (int ai = 0; ai < 2; ++ai)
#pragma unroll
              for (int m = 0; m < 4; ++m)
#pragma unroll
                  for (int bj = 0; bj < 2; ++bj)
#pragma unroll
                      for (int n = 0; n < 2; ++n) acc[ai][bj][m][n] = acc_[ai][bj][m][n] * rs[ai][m]; }
        if (pn >= 10 && pn < 14) {
            const int ch0 = (pn - 10) * 128 + wc * 16 + 4 * fq;
#pragma unroll
            for (int ai = 0; ai < 2; ++ai)
#pragma unroll
                for (int m = 0; m < 4; ++m) { bf16_t* rowp = U + (size_t)(row0 + ai * HALF + m * 16) * DA + ch0;
#pragma unroll
                    for (int bj = 0; bj < 2; ++bj) { const f32x4 a = acc[ai][bj][m][0], b = acc[ai][bj][m][1];
                        v2u w; w.x = pk2(a[0] * b[0], a[1] * b[1]); w.y = pk2(a[2] * b[2], a[3] * b[3]); *(v2u*)(rowp + bj * 64) = w; } }
            return;
        }
        const int colt = wc * 32 + 4 * fq;
        if (pn == 2 || pn == 3) {
            const int c0 = (pn - 2) * 256 + colt;
#pragma unroll
            for (int bj = 0; bj < 2; ++bj)
#pragma unroll
                for (int n = 0; n < 2; ++n) { const int c = c0 + bj * HALF + n * 16;
                    const f32x4 l0 = *(const f32x4*)(lbl + c), l1 = *(const f32x4*)(lbl + 512 + c); f32x4 lb;
#pragma unroll
                    for (int i = 0; i < 4; ++i) lb[i] = sigmoidf_(l0[i] - l1[i]);
#pragma unroll
                    for (int ai = 0; ai < 2; ++ai)
#pragma unroll
                        for (int m = 0; m < 4; ++m) { const f32x4 z = acc[ai][bj][m][n]; f32x4 o;
#pragma unroll
                            for (int i = 0; i < 4; ++i) o[i] = __logf(lb[i] + (1.0f - lb[i]) * sigmoidf_(z[i]));
                            *(f32x4*)(LOGF + (size_t)(row0 + ai * HALF + m * 16) * DA + c) = o; } }
            return;
        }
        bf16_t* base; int ld, c0, act;
        if (pn < 2) { base = Q; ld = DA; c0 = pn * 256; act = 0; }
        else if (pn < 6) { base = V; ld = DA; c0 = (pn - 4) * 256; act = 0; }
        else if (pn < 8) { base = OG; ld = DA; c0 = (pn - 6) * 256; act = 1; }
        else if (pn < 10) { base = BG; ld = DA; c0 = (pn - 8) * 256; act = 0; }
        else if (pn < 18) { base = SGA; ld = DM; c0 = (pn - 14) * 256; act = 2; }
        else { base = SGB; ld = DM; c0 = (pn - 18) * 256; act = 2; }
        c0 += colt;
#pragma unroll
        for (int ai = 0; ai < 2; ++ai)
#pragma unroll
            for (int m = 0; m < 4; ++m) { bf16_t* rowp = base + (size_t)(row0 + ai * HALF + m * 16) * ld + c0;
#pragma unroll
                for (int bj = 0; bj < 2; ++bj)
#pragma unroll
                    for (int n = 0; n < 2; ++n) { f32x4 a = acc[ai][bj][m][n];
                        if (act == 1) { a[0] = siluf_(a[0]); a[1] = siluf_(a[1]); a[2] = siluf_(a[2]); a[3] = siluf_(a[3]); }
                        else if (act == 2) { a[0] = sigmoidf_(a[0]); a[1] = sigmoidf_(a[1]); a[2] = sigmoidf_(a[2]); a[3] = sigmoidf_(a[3]); }
                        v2u w; w.x = pk2(a[0], a[1]); w.y = pk2(a[2], a[3]); *(v2u*)(rowp + bj * HALF + n * 16) = w; } }
    }
};
}

struct Frame {
    LAS unsigned char* lds;
    volatile LAS unsigned* MISC;
    gu32* ctl;
    int tid, lane, wave, vcu, G;
};
struct Args { const float* in[21]; float* out; unsigned char* ws; unsigned mask; unsigned pad; };
typedef const __attribute__((address_space(4))) Args* KArgs;
__device__ __forceinline__ const float* kin(int k) { KArgs p = (KArgs)__builtin_amdgcn_kernarg_segment_ptr(); asm volatile("" : "+s"(p)); return p->in[k]; }

__device__ __forceinline__ float wave_sum(float v) {
#pragma unroll
    for (int o = 1; o < 64; o <<= 1) v += __shfl_xor(v, o);
    return v;
}
__device__ __forceinline__ void transpose_item(const float* W, const float* g, int ldw, int K, int ncols, bf16* WT, int mode, int roff, LAS float* scr, int item, int lane) {
    const int nblk = ncols / 32, kb = item / nblk, nb = item % nblk, k0 = 64 * kb, n0 = 32 * nb;
    const float g0 = g ? g[k0 + lane] : 1.0f;
#pragma unroll 8
    for (int i = 0; i < 32; ++i) { const int kk = 2 * i + (lane >> 5); scr[kk * 33 + (lane & 31)] = W[(size_t)(k0 + kk) * ldw + n0 + (lane & 31)] * __shfl(g0, kk); }
    LDS_WAIT(); asm volatile("" ::: "memory");
    const int c = lane & 7;
#pragma unroll
    for (int j = 0; j < 4; ++j) { const int n = (lane >> 3) + 8 * j; const LAS float* s = scr + (8 * c) * 33 + n;
        v4u o; o.x = pk2(s[0 * 33], s[1 * 33]); o.y = pk2(s[2 * 33], s[3 * 33]); o.z = pk2(s[4 * 33], s[5 * 33]); o.w = pk2(s[6 * 33], s[7 * 33]);
        const int jc = n0 + n; const int drow = mode ? roff + ((jc >> 4) << 5) + (jc & 15) : roff + jc;
        *(GAS v4u*)(WT + (size_t)drow * K + k0 + 8 * c) = o; }
    LDS_WAIT(); asm volatile("" ::: "memory");
}
__device__ __forceinline__ void conv_mat(const float* W, const float* g, int ldw, int K, int ncols, bf16* WT, int mode, int roff, LAS float* scr, int lane, int gw, int NGW) {
    const int nitems = (K / 64) * (ncols / 32);
    for (int it = gw; it < nitems; it += NGW) transpose_item(W, g, ldw, K, ncols, WT, mode, roff, scr, it, lane);
}
__device__ __forceinline__ void conv_w13(const float* w1, const float* w3, const float* g, unsigned char* ws, LAS float* scr, int lane, int gw, int NGW) {
    bf16* W13 = (bf16*)(ws + WS_W13);
    conv_mat(w1, g, DFF, DM, DFF, W13, 1, 0, scr, lane, gw, NGW);
    conv_mat(w3, g, DFF, DM, DFF, W13, 1, 16, scr, lane, (gw + NGW / 2) % NGW, NGW);
}
__device__ __forceinline__ void conv_w2(const float* w2, unsigned char* ws, LAS float* scr, int lane, int gw, int NGW) {
    conv_mat(w2, nullptr, DM, DFF, DM, (bf16*)(ws + WS_W2), 0, 0, scr, lane, gw, NGW);
}
__device__ __forceinline__ void rms_row2_bf16(const float* xrowA, const float* xrowB, const float* g, bf16* orowA, bf16* orowB, int lane) {
    const int hl = lane & 31, hw = lane >> 5;
    const GAS f32x4* xr = (const GAS f32x4*)(hw ? xrowB : xrowA) + hl; const GAS f32x4* gr = (const GAS f32x4*)g + hl;
    f32x4 v[8]; float s = 0.f;
#pragma unroll
    for (int j = 0; j < 8; ++j) { v[j] = xr[32 * j]; s += (v[j].x * v[j].x + v[j].y * v[j].y) + (v[j].z * v[j].z + v[j].w * v[j].w); }
#pragma unroll
    for (int o = 1; o < 32; o <<= 1) s += __shfl_xor(s, o);
    const float rstd = 1.f / sqrtf(s * (1.f / DM) + EPS);
    GAS v2u* o8 = (GAS v2u*)(hw ? orowB : orowA) + hl;
#pragma unroll
    for (int j = 0; j < 8; ++j) { const f32x4 gg = gr[32 * j]; v2u w; w.x = pk2(v[j].x * rstd * gg.x, v[j].y * rstd * gg.y); w.y = pk2(v[j].z * rstd * gg.z, v[j].w * rstd * gg.w); o8[32 * j] = w; }
}
__device__ __forceinline__ void rms_row2_f32(float* xrow0, const float* g, int lane, bool second_valid) {
    const int hl = lane & 31, hw = lane >> 5;
    if (hw && !second_valid) return;
    GAS f32x4* xr = (GAS f32x4*)(xrow0 + (size_t)hw * DM) + hl; const GAS f32x4* gr = (const GAS f32x4*)g + hl;
    f32x4 v[8]; float s = 0.f;
#pragma unroll
    for (int j = 0; j < 8; ++j) { v[j] = NTL(xr + 32 * j); s += (v[j].x * v[j].x + v[j].y * v[j].y) + (v[j].z * v[j].z + v[j].w * v[j].w); }
#pragma unroll
    for (int o = 1; o < 32; o <<= 1) s += __shfl_xor(s, o);
    const float rstd = 1.f / sqrtf(s * (1.f / DM) + EPS);
#pragma unroll
    for (int j = 0; j < 8; ++j) { const f32x4 gg = gr[32 * j]; xr[32 * j] = v[j] * rstd * gg; }
}

__device__ __forceinline__ void hg_prep(const Frame& F, unsigned char* ws, unsigned char* sfr) {
    LAS unsigned char* L = F.lds;
    LAS float* LB = (LAS float*)L;
    LAS bf16* QD = (LAS bf16*)(L + 16896);
    LAS bf16* KD = (LAS bf16*)(L + 16896 + 8704);
    LAS bf16* KET = (LAS bf16*)(L + 16896 + 2 * 8704);
    LAS bf16* VT = (LAS bf16*)(L + 16896 + 2 * 8704 + 10240);
    LAS bf16* SC = (LAS bf16*)(L + 16896 + 2 * 8704 + 2 * 10240);
    const bf16* Qg = (const bf16*)(ws + WS_Q); const bf16* Vg = (const bf16*)(ws + WS_V); const float* LFg = (const float*)(ws + WS_LOGF);
    const int tid = F.tid, c = tid >> 4, kg = tid & 15, lane = F.lane, wave = F.wave;
    for (int u = F.vcu; u < 2048 + NSEQ_S; u += F.G) {
        int t0, nvalid, h; unsigned char *qf, *vf, *lf; int qp, lp;
        if (u < 2048) { const int b = u >> 8, n = u & 63; h = (u >> 6) & 3; t0 = b * 2048 + n * 32; nvalid = 32;
            const size_t e0 = (size_t)t0 * DA + h * 128; qf = ws + WS_Q + e0 * 2; vf = ws + WS_V + e0 * 2; lf = ws + WS_LOGF + e0 * 4; qp = 1024; lp = 2048; }
        else { const int su = u - 2048, b = su >> 2; h = su & 3; t0 = TP + b * 8; nvalid = 8;
            unsigned char* base = sfr + (size_t)su * 65536; qf = base; vf = base + 8192; lf = base + 16384; qp = 256; lp = 512; }
        f32x4 lf0 = {0.f, 0.f, 0.f, 0.f}, lf1 = {0.f, 0.f, 0.f, 0.f}; v4u q8 = {0u, 0u, 0u, 0u}, v8 = {0u, 0u, 0u, 0u};
        if (c < nvalid) { const size_t e = (size_t)(t0 + c) * DA + h * 128 + 8 * kg;
            lf0 = NTL((const GAS f32x4*)(LFg + e)); lf1 = NTL((const GAS f32x4*)(LFg + e + 4)); q8 = NTL((const GAS v4u*)(Qg + e)); v8 = NTL((const GAS v4u*)(Vg + e)); }
        VM_WAIT();
        *(LAS f32x4*)(LB + c * 132 + 8 * kg) = lf0; *(LAS f32x4*)(LB + c * 132 + 8 * kg + 4) = lf1;
        { const unsigned vv[4] = {v8.x, v8.y, v8.z, v8.w};
#pragma unroll
          for (int j = 0; j < 4; ++j) { VT[(8 * kg + 2 * j) * 40 + c] = (bf16)(vv[j] & 0xffffu); VT[(8 * kg + 2 * j + 1) * 40 + c] = (bf16)(vv[j] >> 16); } }
        LDSBAR();
        if (tid < 128) { float run = 0.f;
#pragma unroll 8
            for (int cc = 0; cc < 32; ++cc) { run += LB[cc * 132 + tid]; LB[cc * 132 + tid] = run; } }
        LDSBAR();
        {
            const f32x4 b0 = *(LAS f32x4*)(LB + c * 132 + 8 * kg), b1 = *(LAS f32x4*)(LB + c * 132 + 8 * kg + 4);
            const f32x4 e0 = *(LAS f32x4*)(LB + 31 * 132 + 8 * kg), e1 = *(LAS f32x4*)(LB + 31 * 132 + 8 * kg + 4);
            const unsigned qq[4] = {q8.x, q8.y, q8.z, q8.w};
            float qd[8], kd[8], ke[8];
#pragma unroll
            for (int j = 0; j < 8; ++j) { const float lfj = j < 4 ? lf0[j] : lf1[j - 4], bj = j < 4 ? b0[j] : b1[j - 4], blj = j < 4 ? e0[j] : e1[j - 4];
                const float qj = (j & 1) ? bfhi(qq[j >> 1]) : bflo(qq[j >> 1]);
                const float kin = 1.0f - __expf(lfj);
                qd[j] = qj * __expf(bj); kd[j] = kin * __expf(-bj); ke[j] = kin * __expf(blj - bj); }
            v4u w; w.x = pk2(qd[0], qd[1]); w.y = pk2(qd[2], qd[3]); w.z = pk2(qd[4], qd[5]); w.w = pk2(qd[6], qd[7]);
            *(LAS v4u*)(QD + c * 136 + 8 * kg) = w;
            v4u wk; wk.x = pk2(kd[0], kd[1]); wk.y = pk2(kd[2], kd[3]); wk.z = pk2(kd[4], kd[5]); wk.w = pk2(kd[6], kd[7]);
            *(LAS v4u*)(KD + c * 136 + 8 * kg) = wk;
#pragma unroll
            for (int j = 0; j < 8; ++j) KET[(8 * kg + j) * 40 + c] = (bf16)f2bf(ke[j]);
#pragma unroll
            for (int g = 0; g < 2; ++g) { const int g4 = 2 * kg + g, m = g4 >> 3, r8 = g4 & 7, jh = r8 >> 2, q4 = r8 & 3, ch = c >> 4, lp_ = 16 * q4 + (c & 15);
                const int o = (((ch * 4 + m) * 64 + lp_) << 4) + jh * 8;
                v2u x; x.x = g ? w.z : w.x; x.y = g ? w.w : w.y;
                *(GAS v2u*)(qf + (size_t)(o >> 8) * qp + (o & 255)) = x; }
            if (c == 0) { const int o = 10240 + 32 * kg; unsigned char* p = lf + (size_t)(o >> 9) * lp + (o & 511);
                f32x4 d0, d1;
#pragma unroll
                for (int j = 0; j < 4; ++j) { d0[j] = __expf(e0[j]); d1[j] = __expf(e1[j]); }
                *(GAS f32x4*)p = d0; *(GAS f32x4*)(p + 16) = d1; }
        }
        LDSBAR();
        if (wave < 4) {
            const int cb = wave >> 1, sb = wave & 1, r = lane & 15, q = lane >> 4;
            f32x4 a4 = {0.f, 0.f, 0.f, 0.f};
            if (!(cb == 0 && sb == 1)) {
#pragma unroll
                for (int kk = 0; kk < 4; ++kk) { const bf16x8 a = *(LAS bf16x8*)(QD + (16 * cb + r) * 136 + 32 * kk + 8 * q), bb = *(LAS bf16x8*)(KD + (16 * sb + r) * 136 + 32 * kk + 8 * q);
                    a4 = __builtin_amdgcn_mfma_f32_16x16x32_bf16(a, bb, a4, 0, 0, 0); }
            }
#pragma unroll
            for (int i = 0; i < 4; ++i) { const int cc = 16 * cb + 4 * q + i, ss = 16 * sb + r; SC[cc * 40 + ss] = (bf16)f2bf(cc >= ss ? a4[i] : 0.f); }
        } else {
            const int tt = tid - 256;
#pragma unroll
            for (int rep = 0; rep < 2; ++rep) { const int p = tt + 256 * rep, kb = p >> 6, l2 = p & 63, o = p << 4;
                const v4u x = *(LAS v4u*)(KET + (16 * kb + (l2 & 15)) * 40 + 8 * (l2 >> 4));
                *(GAS v4u*)(lf + (size_t)(o >> 9) * lp + (o & 511)) = x;
                const v4u y = *(LAS v4u*)(VT + (16 * kb + (l2 & 15)) * 40 + 8 * (l2 >> 4));
                *(GAS v4u*)(vf + (size_t)(o >> 8) * qp + (o & 255)) = y; }
        }
        LDSBAR();
        if (tid < 128) { const int p = tid, ch = p >> 6, l2 = p & 63, o = 8192 + (p << 4);
            const v4u x = *(LAS v4u*)(SC + (16 * ch + (l2 & 15)) * 40 + 8 * (l2 >> 4));
            *(GAS v4u*)(lf + (size_t)(o >> 9) * lp + (o & 511)) = x; }
        LDSBAR();
    }
}

struct HgPre { v4u q, v, l0, l1; };
constexpr int HG_SLOT = 27648;
__device__ __forceinline__ void hg_chunk(const LAS unsigned char* sl, f32x4 (&S)[8], float* Orow, int nvalid, int vs, int lane) {
    const int r = lane & 15, q = lane >> 4;
    const bf16x8 vfr = *(const LAS bf16x8*)(sl + 16384 + ((vs * 64 + lane) << 4));
    f32x4 o0 = {0.f, 0.f, 0.f, 0.f}, o1 = {0.f, 0.f, 0.f, 0.f};
    { const bf16x8 s0 = *(const LAS bf16x8*)(sl + 24576 + (lane << 4)), s1 = *(const LAS bf16x8*)(sl + 24576 + ((64 + lane) << 4));
      o0 = __builtin_amdgcn_mfma_f32_16x16x32_bf16(s0, vfr, o0, 0, 0, 0); o1 = __builtin_amdgcn_mfma_f32_16x16x32_bf16(s1, vfr, o1, 0, 0, 0); }
#pragma unroll
    for (int m = 0; m < 4; ++m) {
        v4u sw; sw.x = pk2(S[2 * m][0], S[2 * m][1]); sw.y = pk2(S[2 * m][2], S[2 * m][3]); sw.z = pk2(S[2 * m + 1][0], S[2 * m + 1][1]); sw.w = pk2(S[2 * m + 1][2], S[2 * m + 1][3]);
        const bf16x8 sb = __builtin_bit_cast(bf16x8, sw);
        const bf16x8 a0 = *(const LAS bf16x8*)(sl + ((m * 64 + lane) << 4)), a1 = *(const LAS bf16x8*)(sl + (((4 + m) * 64 + lane) << 4));
        o0 = __builtin_amdgcn_mfma_f32_16x16x32_bf16(a0, sb, o0, 0, 0, 0); o1 = __builtin_amdgcn_mfma_f32_16x16x32_bf16(a1, sb, o1, 0, 0, 0);
    }
#pragma unroll
    for (int i = 0; i < 4; ++i) { const int c0 = 4 * q + i;
        if (c0 < nvalid) Orow[(size_t)c0 * DA + 16 * vs + r] = o0[i];
        if (c0 + 16 < nvalid) Orow[(size_t)(c0 + 16) * DA + 16 * vs + r] = o1[i]; }
#pragma unroll
    for (int kb = 0; kb < 8; ++kb) { const f32x4 d = *(const LAS f32x4*)(sl + 26624 + ((16 * kb + 4 * q) << 2));
        const bf16x8 ke = *(const LAS bf16x8*)(sl + 8192 + ((kb * 64 + lane) << 4));
        S[kb] = __builtin_amdgcn_mfma_f32_16x16x32_bf16(ke, vfr, S[kb] * d, 0, 0, 0); }
}
__device__ __forceinline__ void hg_seq(const Frame& F, unsigned char* ws, const float* s0, float* sout, float* Og, int seq, bool sample, int vs_base, int nvs) {
    LAS unsigned char* ring = F.lds;
    const int tid = F.tid, lane = F.lane, vs = vs_base + F.wave, r = lane & 15, q = lane >> 4;
    const bool active = F.wave < nvs, vload = (unsigned)((tid >> 6) - vs_base) < (unsigned)nvs;
    int nch, nvalid, t0, h; const unsigned char *qf, *vf, *lf; int qp, lp; size_t qstep, lstep;
    if (!sample) { const int b = seq >> 2; h = seq & 3; t0 = b * 2048; nch = 64; nvalid = 32; const size_t e0 = (size_t)t0 * DA + h * 128;
        qf = ws + WS_Q + e0 * 2; vf = ws + WS_V + e0 * 2; lf = ws + WS_LOGF + e0 * 4; qp = 1024; lp = 2048; qstep = 32 * 1024; lstep = 32 * 2048; }
    else { const int b = seq >> 2; h = seq & 3; t0 = TP + b * 8; nch = 1; nvalid = 8; const unsigned char* base = (const unsigned char*)sout + (size_t)seq * 65536;
        qf = base; vf = base + 8192; lf = base + 16384; qp = 256; lp = 512; qstep = 0; lstep = 0; }
    const size_t offq = (size_t)(tid >> 4) * qp + (tid & 15) * 16, offl0 = (size_t)(tid >> 5) * lp + (tid & 31) * 16, offl1 = (size_t)(16 + (tid >> 5)) * lp + (tid & 31) * 16, offl1c = tid < 160 ? offl1 : offl0;
    {
    f32x4 S[8];
    if (sample && active) {
#pragma unroll
        for (int kb = 0; kb < 8; ++kb)
#pragma unroll
            for (int i = 0; i < 4; ++i) S[kb][i] = s0[((size_t)seq * 128 + 16 * kb + 4 * q + i) * 128 + 16 * vs + r];
    } else {
#pragma unroll
        for (int kb = 0; kb < 8; ++kb) S[kb] = (f32x4){0.f, 0.f, 0.f, 0.f};
    }
    float* Ob = Og + (size_t)t0 * DA + h * 128;
#define HG_LOAD(R, n) do { if (sample) { if ((n) < nch) { R.q = NTL((const GAS v4u*)(qf + offq)); if (vload) R.v = NTL((const GAS v4u*)(vf + offq)); R.l0 = NTL((const GAS v4u*)(lf + offl0)); if (tid < 160) R.l1 = NTL((const GAS v4u*)(lf + offl1)); } } \
        else { const int n_ = (n) < nch ? (n) : nch - 1; const unsigned char* q_ = qf + (size_t)n_ * qstep; const unsigned char* v_ = vf + (size_t)n_ * qstep; const unsigned char* l_ = lf + (size_t)n_ * lstep; \
        R.q = NTL((const GAS v4u*)(q_ + offq)); R.v = NTL((const GAS v4u*)(v_ + offq)); R.l0 = NTL((const GAS v4u*)(l_ + offl0)); R.l1 = NTL((const GAS v4u*)(l_ + offl1c)); } } while (0)
#define HG_STORE(R, s) do { LAS unsigned char* d_ = ring + (s) * HG_SLOT; *(LAS v4u*)(d_ + 16 * tid) = R.q; if (vload) *(LAS v4u*)(d_ + 16384 + 16 * tid) = R.v; *(LAS v4u*)(d_ + 8192 + 16 * tid) = R.l0; \
        if (tid < 160) *(LAS v4u*)(d_ + 24576 + 16 * tid) = R.l1; } while (0)
    HgPre R0, R1, R2, R3, R4, R5;
    R0.l1 = R0.v = (v4u){0u, 0u, 0u, 0u}; R1.l1 = R1.v = (v4u){0u, 0u, 0u, 0u}; R2.l1 = R2.v = (v4u){0u, 0u, 0u, 0u}; R3.l1 = R3.v = (v4u){0u, 0u, 0u, 0u}; R4.l1 = R4.v = (v4u){0u, 0u, 0u, 0u}; R5.l1 = R5.v = (v4u){0u, 0u, 0u, 0u};
    HG_LOAD(R0, 0); HG_LOAD(R1, 1); HG_LOAD(R2, 2); HG_LOAD(R3, 3); HG_LOAD(R4, 4);
    HG_STORE(R0, 0); LDSBAR();
    for (int n = 0; n < nch; n += 6) {
        HG_LOAD(R5, n + 5); if (active) hg_chunk(ring, S, Ob + (size_t)(n + 0) * 32 * DA, nvalid, vs, lane); if (n + 1 < nch) HG_STORE(R1, 1); LDSBAR(); if (n + 1 >= nch) break;
        HG_LOAD(R0, n + 6); if (active) hg_chunk(ring + HG_SLOT, S, Ob + (size_t)(n + 1) * 32 * DA, nvalid, vs, lane); if (n + 2 < nch) HG_STORE(R2, 0); LDSBAR(); if (n + 2 >= nch) break;
        HG_LOAD(R1, n + 7); if (active) hg_chunk(ring, S, Ob + (size_t)(n + 2) * 32 * DA, nvalid, vs, lane); if (n + 3 < nch) HG_STORE(R3, 1); LDSBAR(); if (n + 3 >= nch) break;
        HG_LOAD(R2, n + 8); if (active) hg_chunk(ring + HG_SLOT, S, Ob + (size_t)(n + 3) * 32 * DA, nvalid, vs, lane); if (n + 4 < nch) HG_STORE(R4, 0); LDSBAR(); if (n + 4 >= nch) break;
        HG_LOAD(R3, n + 9); if (active) hg_chunk(ring, S, Ob + (size_t)(n + 4) * 32 * DA, nvalid, vs, lane); if (n + 5 < nch) HG_STORE(R5, 1); LDSBAR(); if (n + 5 >= nch) break;
        HG_LOAD(R4, n + 10); if (active) hg_chunk(ring + HG_SLOT, S, Ob + (size_t)(n + 5) * 32 * DA, nvalid, vs, lane); if (n + 6 < nch) HG_STORE(R0, 0); LDSBAR();
    }
    if (active) {
#pragma unroll
    for (int kb = 0; kb < 8; ++kb)
#pragma unroll
        for (int i = 0; i < 4; ++i) sout[((size_t)seq * 128 + 16 * kb + 4 * q + i) * 128 + 16 * vs + r] = S[kb][i];
    }
    LDSBAR();
    }
}


#undef HG_LOAD
#undef HG_STORE
struct SgPre { v4u a0, a1, b0, b1; };
template <class Epi>
__device__ __forceinline__ void small_gemm(const Frame& F, const bf16* A, const bf16* Bt, int row_base, int K, const Epi E) {
    constexpr int LDT = 136, BUF = 64 * LDT;
    LAS bf16* As = (LAS bf16*)F.lds; LAS bf16* Bs = As + 2 * BUF;
    const int tid = F.tid, lane = F.lane, w = F.wave, r = lane & 15, q = lane >> 4, prow = tid >> 3, pk = (tid & 7) * 8, ns = K / 128;
    for (int u = F.vcu; u < 256; u += F.G) {
        const int r0 = row_base + (u >> 4) * 64, c0 = (u & 15) * 64;
        const bf16* ap = A + (size_t)(r0 + prow) * K + pk; const bf16* bp = Bt + (size_t)(c0 + prow) * K + pk;
        f32x4 acc0 = {0.f, 0.f, 0.f, 0.f}, acc1 = {0.f, 0.f, 0.f, 0.f};
        const typename Epi::Pre ep0 = E.pre4(r0 + 16 * (w & 3) + r, c0 + 32 * (w >> 2) + 4 * q), ep1 = E.pre4(r0 + 16 * (w & 3) + r, c0 + 32 * (w >> 2) + 16 + 4 * q);
#define SG_LOAD(R, s_) do { if ((s_) < ns) { R.a0 = NTL((const GAS v4u*)(ap + (s_) * 128)); R.a1 = NTL((const GAS v4u*)(ap + (s_) * 128 + 64)); R.b0 = NTL((const GAS v4u*)(bp + (s_) * 128)); R.b1 = NTL((const GAS v4u*)(bp + (s_) * 128 + 64)); } } while (0)
#define SG_STORE(R, b_) do { *(LAS v4u*)(As + (b_) * BUF + prow * LDT + pk) = R.a0; *(LAS v4u*)(As + (b_) * BUF + prow * LDT + pk + 64) = R.a1; *(LAS v4u*)(Bs + (b_) * BUF + prow * LDT + pk) = R.b0; *(LAS v4u*)(Bs + (b_) * BUF + prow * LDT + pk + 64) = R.b1; } while (0)
#define SG_COMP(b_) do { _Pragma("unroll") for (int kk = 0; kk < 4; ++kk) { \
            const bf16x8 a_ = *(const LAS bf16x8*)(As + (b_) * BUF + (16 * (w & 3) + r) * LDT + 32 * kk + 8 * q); \
            const bf16x8 x0_ = *(const LAS bf16x8*)(Bs + (b_) * BUF + (32 * (w >> 2) + r) * LDT + 32 * kk + 8 * q), x1_ = *(const LAS bf16x8*)(Bs + (b_) * BUF + (32 * (w >> 2) + 16 + r) * LDT + 32 * kk + 8 * q); \
            acc0 = __builtin_amdgcn_mfma_f32_16x16x32_bf16(x0_, a_, acc0, 0, 0, 0); acc1 = __builtin_amdgcn_mfma_f32_16x16x32_bf16(x1_, a_, acc1, 0, 0, 0); } } while (0)
        SgPre R0, R1, R2, R3;
        SG_LOAD(R0, 0); SG_LOAD(R1, 1); SG_LOAD(R2, 2);
        SG_STORE(R0, 0); LDSBAR();
        for (int s = 0; s < ns; s += 4) {
            SG_LOAD(R3, s + 3); SG_COMP(0); if (s + 1 < ns) SG_STORE(R1, 1); LDSBAR(); if (s + 1 >= ns) break;
            SG_LOAD(R0, s + 4); SG_COMP(1); if (s + 2 < ns) SG_STORE(R2, 0); LDSBAR(); if (s + 2 >= ns) break;
            SG_LOAD(R1, s + 5); SG_COMP(0); if (s + 3 < ns) SG_STORE(R3, 1); LDSBAR(); if (s + 3 >= ns) break;
            SG_LOAD(R2, s + 6); SG_COMP(1); if (s + 4 < ns) SG_STORE(R0, 0); LDSBAR();
        }
#undef SG_LOAD
#undef SG_STORE
#undef SG_COMP
        { float ss = E.store4p(r0 + 16 * (w & 3) + r, c0 + 32 * (w >> 2) + 4 * q, acc0, ep0);
          ss += E.store4p(r0 + 16 * (w & 3) + r, c0 + 32 * (w >> 2) + 16 + 4 * q, acc1, ep1);
          if (E.has_norm()) {
              LAS float* RS_ = (LAS float*)F.lds;
              ss += __shfl_xor(ss, 16); ss += __shfl_xor(ss, 32);
              if (q == 0) RS_[(w >> 2) * 64 + 16 * (w & 3) + r] = ss;
              LDSBAR();
              if (tid < 64) E.row_store_s(r0 + tid, u & 15, RS_[tid] + RS_[64 + tid]);
              LDSBAR(); } }
    }
}


__device__ __forceinline__ void small_gemm_dual(const Frame& F, const bf16* ZA, const bf16* WA, const bf16* ZB, const bf16* WB, const bf16* SGA, const bf16* SGB, bf16* MG, int row_base) {
    constexpr int K = DA, LDT = 72, ARR = 64 * LDT, BUF = 4 * ARR, ns = K / 64;
    LAS bf16* L = (LAS bf16*)F.lds;
    const int tid = F.tid, lane = F.lane, w = F.wave, r = lane & 15, q = lane >> 4, prow = tid >> 3, pk = (tid & 7) * 8;
    for (int u = F.vcu; u < 256; u += F.G) {
        const int r0 = row_base + (u >> 4) * 64, c0 = (u & 15) * 64;
        const bf16* a1p = ZA + (size_t)(r0 + prow) * K + pk; const bf16* b1p = WA + (size_t)(c0 + prow) * K + pk;
        const bf16* a2p = ZB + (size_t)(r0 + prow) * K + pk; const bf16* b2p = WB + (size_t)(c0 + prow) * K + pk;
        const int orow = r0 + 16 * (w & 3) + r, ocol = c0 + 32 * (w >> 2) + 4 * q;
        const size_t o0 = (size_t)orow * DM + ocol, o1 = o0 + 16;
        const v2u ga0 = NTL((const GAS v2u*)(SGA + o0)), ga1 = NTL((const GAS v2u*)(SGA + o1)), gb0 = NTL((const GAS v2u*)(SGB + o0)), gb1 = NTL((const GAS v2u*)(SGB + o1));
        f32x4 aa0 = {0.f, 0.f, 0.f, 0.f}, aa1 = aa0, ab0 = aa0, ab1 = aa0;
#define SD_LOAD(R, s_) do { const int c_ = (s_) < ns ? (s_) : ns - 1; R.a0 = NTL((const GAS v4u*)(a1p + c_ * 64)); R.a1 = NTL((const GAS v4u*)(b1p + c_ * 64)); R.b0 = NTL((const GAS v4u*)(a2p + c_ * 64)); R.b1 = NTL((const GAS v4u*)(b2p + c_ * 64)); } while (0)
#define SD_STORE(R, b_) do { LAS bf16* d_ = L + (b_) * BUF + prow * LDT + pk; *(LAS v4u*)(d_) = R.a0; *(LAS v4u*)(d_ + ARR) = R.a1; *(LAS v4u*)(d_ + 2 * ARR) = R.b0; *(LAS v4u*)(d_ + 3 * ARR) = R.b1; } while (0)
#define SD_COMP(b_) do { const LAS bf16* s_ = L + (b_) * BUF; _Pragma("unroll") for (int kk = 0; kk < 2; ++kk) { const int ko_ = 32 * kk + 8 * q; \
            const bf16x8 a1_ = *(const LAS bf16x8*)(s_ + (16 * (w & 3) + r) * LDT + ko_), a2_ = *(const LAS bf16x8*)(s_ + 2 * ARR + (16 * (w & 3) + r) * LDT + ko_); \
            const bf16x8 x10_ = *(const LAS bf16x8*)(s_ + ARR + (32 * (w >> 2) + r) * LDT + ko_), x11_ = *(const LAS bf16x8*)(s_ + ARR + (32 * (w >> 2) + 16 + r) * LDT + ko_); \
            const bf16x8 x20_ = *(const LAS bf16x8*)(s_ + 3 * ARR + (32 * (w >> 2) + r) * LDT + ko_), x21_ = *(const LAS bf16x8*)(s_ + 3 * ARR + (32 * (w >> 2) + 16 + r) * LDT + ko_); \
            aa0 = __builtin_amdgcn_mfma_f32_16x16x32_bf16(x10_, a1_, aa0, 0, 0, 0); aa1 = __builtin_amdgcn_mfma_f32_16x16x32_bf16(x11_, a1_, aa1, 0, 0, 0); \
            ab0 = __builtin_amdgcn_mfma_f32_16x16x32_bf16(x20_, a2_, ab0, 0, 0, 0); ab1 = __builtin_amdgcn_mfma_f32_16x16x32_bf16(x21_, a2_, ab1, 0, 0, 0); } } while (0)
        SgPre R0, R1, R2, R3;
        SD_LOAD(R0, 0); SD_LOAD(R1, 1); SD_LOAD(R2, 2);
        SD_STORE(R0, 0); LDSBAR();
        for (int s = 0; s < ns; s += 4) {
            SD_LOAD(R3, s + 3); SD_COMP(0); if (s + 1 < ns) SD_STORE(R1, 1); LDSBAR(); if (s + 1 >= ns) break;
            SD_LOAD(R0, s + 4); SD_COMP(1); if (s + 2 < ns) SD_STORE(R2, 0); LDSBAR(); if (s + 2 >= ns) break;
            SD_LOAD(R1, s + 5); SD_COMP(0); if (s + 3 < ns) SD_STORE(R3, 1); LDSBAR(); if (s + 3 >= ns) break;
            SD_LOAD(R2, s + 6); SD_COMP(1); if (s + 4 < ns) SD_STORE(R0, 0); LDSBAR();
        }
#undef SD_LOAD
#undef SD_STORE
#undef SD_COMP
        { v2u w0; w0.x = pk2(bflo(ga0.x) * aa0[0] + bflo(gb0.x) * ab0[0], bfhi(ga0.x) * aa0[1] + bfhi(gb0.x) * ab0[1]); w0.y = pk2(bflo(ga0.y) * aa0[2] + bflo(gb0.y) * ab0[2], bfhi(ga0.y) * aa0[3] + bfhi(gb0.y) * ab0[3]);
          *(GAS v2u*)(MG + o0) = w0;
          v2u w1; w1.x = pk2(bflo(ga1.x) * aa1[0] + bflo(gb1.x) * ab1[0], bfhi(ga1.x) * aa1[1] + bfhi(gb1.x) * ab1[1]); w1.y = pk2(bflo(ga1.y) * aa1[2] + bflo(gb1.y) * ab1[2], bfhi(ga1.y) * aa1[3] + bfhi(gb1.y) * ab1[3]);
          *(GAS v2u*)(MG + o1) = w1; }
    }
}

__device__ __forceinline__ void zb_rows(unsigned char* ws, const float* cw, const float* st_c, float* out, int lane, int gw, int NGW) {
    bf16* BGb = (bf16*)(ws + WS_BG); const bf16* Ub = (const bf16*)(ws + WS_U);
    const int hl = lane & 31, hw = lane >> 5, c0 = 16 * hl;
    for (int t = 2 * gw + hw; t < T; t += 2 * NGW) {
        const bool smp = t >= TP; const int pos = smp ? ((t - TP) & 7) : (t & 2047), L = smp ? 8 : 2048, bb = smp ? ((t - TP) >> 3) : (t >> 11);
        const size_t e = (size_t)t * DA + c0;
        v4u bg[2], u0[2], x1[2], x2[2];
#pragma unroll
        for (int h = 0; h < 2; ++h) { bg[h] = NTL((const GAS v4u*)(BGb + e + 8 * h)); u0[h] = NTL((const GAS v4u*)(Ub + e + 8 * h));
            x1[h] = (pos >= 1) ? NTL((const GAS v4u*)(Ub + e - DA + 8 * h)) : (v4u){0u, 0u, 0u, 0u};
            x2[h] = (pos >= 2) ? NTL((const GAS v4u*)(Ub + e - 2 * DA + 8 * h)) : (v4u){0u, 0u, 0u, 0u}; }
#pragma unroll
        for (int h = 0; h < 2; ++h) {
            float um1[8], um2[8];
            { const v4u x = x1[h]; um1[0] = bflo(x.x); um1[1] = bfhi(x.x); um1[2] = bflo(x.y); um1[3] = bfhi(x.y); um1[4] = bflo(x.z); um1[5] = bfhi(x.z); um1[6] = bflo(x.w); um1[7] = bfhi(x.w); }
            { const v4u x = x2[h]; um2[0] = bflo(x.x); um2[1] = bfhi(x.x); um2[2] = bflo(x.y); um2[3] = bfhi(x.y); um2[4] = bflo(x.z); um2[5] = bfhi(x.z); um2[6] = bflo(x.w); um2[7] = bfhi(x.w); }
            if (smp && pos < 1) { const size_t so = ((size_t)bb * 2 + 1) * DA + c0 + 8 * h; const f32x4 a = *(const GAS f32x4*)(st_c + so), b = *(const GAS f32x4*)(st_c + so + 4);
                um1[0] = a.x; um1[1] = a.y; um1[2] = a.z; um1[3] = a.w; um1[4] = b.x; um1[5] = b.y; um1[6] = b.z; um1[7] = b.w; }
            if (smp && pos < 2) { const size_t so = ((size_t)bb * 2 + pos) * DA + c0 + 8 * h; const f32x4 a = *(const GAS f32x4*)(st_c + so), b = *(const GAS f32x4*)(st_c + so + 4);
                um2[0] = a.x; um2[1] = a.y; um2[2] = a.z; um2[3] = a.w; um2[4] = b.x; um2[5] = b.y; um2[6] = b.z; um2[7] = b.w; }
            const unsigned uw[4] = {u0[h].x, u0[h].y, u0[h].z, u0[h].w}, bw[4] = {bg[h].x, bg[h].y, bg[h].z, bg[h].w};
            const f32x4 w0a = *(const GAS f32x4*)(cw + c0 + 8 * h), w0b = *(const GAS f32x4*)(cw + c0 + 8 * h + 4), w1a = *(const GAS f32x4*)(cw + DA + c0 + 8 * h), w1b = *(const GAS f32x4*)(cw + DA + c0 + 8 * h + 4),
                        w2a = *(const GAS f32x4*)(cw + 2 * DA + c0 + 8 * h), w2b = *(const GAS f32x4*)(cw + 2 * DA + c0 + 8 * h + 4);
            float zb[8], uf[8];
#pragma unroll
            for (int j = 0; j < 8; ++j) { uf[j] = (j & 1) ? bfhi(uw[j >> 1]) : bflo(uw[j >> 1]); const float bgj = (j & 1) ? bfhi(bw[j >> 1]) : bflo(bw[j >> 1]);
                const float w0 = j < 4 ? w0a[j & 3] : w0b[j & 3], w1 = j < 4 ? w1a[j & 3] : w1b[j & 3], w2 = j < 4 ? w2a[j & 3] : w2b[j & 3];
                zb[j] = bgj * (w0 * um2[j] + w1 * um1[j] + w2 * uf[j]); }
            v4u zw; zw.x = pk2(zb[0], zb[1]); zw.y = pk2(zb[2], zb[3]); zw.z = pk2(zb[4], zb[5]); zw.w = pk2(zb[6], zb[7]);
            *(GAS v4u*)(BGb + e + 8 * h) = zw;
            if (pos >= L - 2) { float* so = out + (smp ? OUT_SCS : OUT_SCP) + ((size_t)bb * 2 + (pos - (L - 2))) * DA + c0 + 8 * h;
                *(GAS f32x4*)so = (f32x4){uf[0], uf[1], uf[2], uf[3]}; *(GAS f32x4*)(so + 4) = (f32x4){uf[4], uf[5], uf[6], uf[7]}; }
        }
    }
}


__device__ __forceinline__ int unit_pm_n5632(int L) { const int wgid = (L % 8) * 187 + L / 8, gid = wgid / 176, fm = gid * 8, gsz = (68 - fm) < 8 ? (68 - fm) : 8; return fm + ((wgid % 176) % gsz); }
__device__ __forceinline__ void rstd_prefetch(const Frame& F, const float* PP, const float* PS) {
    LAS int* PMT = (LAS int*)(F.lds + PMT_OFF); LAS float* RSL = (LAS float*)(F.lds + RSL_OFF);
    for (int i = 0; i < RSL_SLOTS; ++i) { const int L = i * F.G + (int)blockIdx.x; const bool ok = (L < 1496) && (F.G % 8 == 0);
        const int pm = ok ? unit_pm_n5632(L) : -1;
        if (ok && F.tid < 256) RSL[i * 256 + F.tid] = pg8::row_rstd(PP, PS, pm * 256 + F.tid);
        if (F.tid == 0) PMT[i] = pm; }
    __syncthreads();
}

__global__ void __launch_bounds__(NWAVES * 64, 2) mk_fwd(Args args) {
    extern __shared__ __attribute__((aligned(16))) unsigned char lds[];
    Frame F;
    F.lds = (LAS unsigned char*)lds;
    F.MISC = (volatile LAS unsigned*)(F.lds + MISC_OFF);
    F.tid = threadIdx.x; F.lane = F.tid & 63; F.wave = __builtin_amdgcn_readfirstlane(F.tid >> 6);
    F.G = gridDim.x; { const int bx = blockIdx.x; F.vcu = (F.G % 8 == 0) ? (bx % 8) * (F.G / 8) + bx / 8 : bx; }
    unsigned char* ws = args.ws;
    F.ctl = (gu32*)(ws + WS_CTL);
    for (int u = F.tid; u < (LDS_BYTES - LDSCTL_OFF) / 4; u += NWAVES * 64) ((LAS unsigned*)(F.lds + LDSCTL_OFF))[u] = 0u;
    __syncthreads();
    XcdBarrier bar = xcd_barrier_post((unsigned*)(F.ctl + CW_BAR), F.MISC + 8);
#define GRID_BAR() do { xcd_barrier(bar); REFRESH(); } while (0)
    float* out = args.out;
    bf16* XN = (bf16*)(ws + WS_XN); bf16* Hb = (bf16*)(ws + WS_H);
    const int NGW = F.G * NWAVES;
    const unsigned phmask = args.mask;
    const int first_idle = 1496 % F.G, n_idle = first_idle ? F.G - first_idle : F.G, my_idle = first_idle ? (int)blockIdx.x - first_idle : (int)blockIdx.x;
    const int INGW = n_idle * NWAVES;
#define IGW_ (my_idle * NWAVES + F.wave)
#if defined(PROBE_F) || defined(PROBE_G)
    int probe_two = 2; asm volatile("" : "+s"(probe_two));
#endif
#define GW_ (F.vcu * NWAVES + F.wave)
#define PARTP_ ((float*)(ws + WS_PARTP))
#define PARTS_ ((float*)(ws + WS_PARTS))
#define SCR_ ((LAS float*)(F.lds + F.wave * 16384))
#define REFRESH() do { int t_ = threadIdx.x; asm volatile("" : "+v"(t_)); F.tid = t_; F.lane = t_ & 63; F.wave = __builtin_amdgcn_readfirstlane(t_ >> 6); } while (0)

    if (phmask & (1u << 0)) {
#ifdef PROBE_C
    for (int rep_ = 0; rep_ < 3; ++rep_)
#endif
    {
        conv_w13(kin(6), kin(7), nullptr, ws, SCR_, F.lane, GW_, NGW);
        conv_w2(kin(8), ws, SCR_, F.lane, (GW_ + NGW / 4) % NGW, NGW);
        { const float* win = kin(10); bf16* WIN = (bf16*)(ws + WS_WIN);
          conv_mat(win, nullptr, NIN, DM, 2560, WIN, 0, 0, SCR_, F.lane, (GW_ + NGW / 2) % NGW, NGW);
          conv_mat(win + 2560, nullptr, NIN, DM, 512, WIN, 1, 2560, SCR_, F.lane, (GW_ + NGW / 8) % NGW, NGW);
          conv_mat(win + 3072, nullptr, NIN, DM, 512, WIN, 1, 2560 + 16, SCR_, F.lane, (GW_ + 3 * (NGW / 8)) % NGW, NGW);
          conv_mat(win + 3584, nullptr, NIN, DM, 2048, WIN, 0, 3584, SCR_, F.lane, (GW_ + 3 * (NGW / 4)) % NGW, NGW); }
        { const float* xp = kin(0); const float* xs = kin(1); const float* g1 = kin(5);
          for (int m = 2 * GW_; m < T; m += 2 * NGW) { const float* ra = m < TP ? xp + (size_t)m * DM : xs + (size_t)(m - TP) * DM;
              rms_row2_bf16(ra, ra + DM, g1, XN + (size_t)m * DM, XN + (size_t)(m + 1) * DM, F.lane); } }
    }
    GRID_BAR();
#ifdef PROBE_E
    for (int rep_ = 0; rep_ < 10; ++rep_) GRID_BAR();
#endif
#if defined(PROBE_E2) || defined(PROBE_E3) || defined(PROBE_E4) || defined(PROBE_E5)
    for (int rep_ = 0; rep_ < 10; ++rep_) xcd_barrier_probe(bar);
#endif
    }

    if (phmask & (1u << 1)) {
#ifdef PROBE_F
    _Pragma("clang loop unroll(disable)") for (int rep_ = 0; rep_ < probe_two; ++rep_)
#endif
    { pg8::Gemm g{XN, (const bf16*)(ws + WS_W13), T, 2 * DFF, DM}; pg8::StaticOrder S; S.init(T, 2 * DFF, F.G, (int)blockIdx.x);
      pg8::EpiSwiglu E{Hb, DFF, nullptr, nullptr, F.lds}; pg8::gemm_phase<pg8::EpiSwiglu, pg8::StaticOrder, true, true>(F.lds, g, S, E); }
    GRID_BAR();
    }

    if (phmask & (1u << 2)) {
#ifdef PROBE_G
    _Pragma("clang loop unroll(disable)") for (int rep_ = 0; rep_ < probe_two; ++rep_)
#endif
    { pg8::Gemm g{Hb, (const bf16*)(ws + WS_W2), TP, DM, DFF}; pg8::StaticOrder S; S.init(TP, DM, F.G, (int)blockIdx.x);
      pg8::EpiRes<true> E{kin(0), kin(1), out, XN, PARTP_, PARTS_, F.lds, kin(9)}; pg8::gemm_phase<pg8::EpiRes<true>, pg8::StaticOrder, true, true>(F.lds, g, S, E);
      small_gemm(F, Hb, (const bf16*)(ws + WS_W2), TP, DFF, pg8::EpiRes<true>{kin(0), kin(1), out, XN, PARTP_, PARTS_, F.lds, kin(9)}); }
    GRID_BAR();
    }

    if (phmask & (1u << 3)) {
    rstd_prefetch(F, PARTP_, PARTS_);
    { pg8::Gemm g{XN, (const bf16*)(ws + WS_WIN), T, NIN, DM}; pg8::StaticOrder S; S.init(T, NIN, F.G, (int)blockIdx.x);
      pg8::EpiMix E{(bf16*)(ws + WS_Q), (bf16*)(ws + WS_V), (bf16*)(ws + WS_OG), (bf16*)(ws + WS_BG), (bf16*)(ws + WS_U), (bf16*)(ws + WS_SGA), (bf16*)(ws + WS_SGB), (float*)(ws + WS_LOGF), kin(4), PARTP_, PARTS_, F.lds};
      pg8::gemm_phase<pg8::EpiMix, pg8::StaticOrder, true, true>(F.lds, g, S, E); }
    GRID_BAR();
    }

    if (phmask & (1u << 4)) {
    hg_prep(F, ws, (unsigned char*)(out + OUT_SHS));
    GRID_BAR();
    }

    if (phmask & (1u << 5)) {
    {
        float* Og = (float*)(ws + WS_XN); const float* st_h = kin(2); const float* st_c = kin(3);
        const int bid = (int)blockIdx.x, G = F.G;
        constexpr int NSCAN = 4 * NSEQ_P;
        if (G >= 2 * NSCAN) {
            for (int s = bid; s < NSEQ_S; s += G) hg_seq(F, ws, st_h, out + OUT_SHS, Og, s, true, 0, 8);
            if (bid < NSCAN) hg_seq(F, ws, nullptr, out + OUT_SHP, Og, bid >> 2, false, 2 * (bid & 3), 2);
            else {
                REFRESH();
                const int cgw = (bid - NSCAN) * NWAVES + F.wave, CNGW = (G - NSCAN) * NWAVES;
                zb_rows(ws, kin(11), st_c, out, F.lane, cgw, CNGW);
                conv_mat(kin(13), nullptr, DM, DA, DM, (bf16*)(ws + WS_WA), 0, 0, SCR_, F.lane, cgw, CNGW);
                conv_mat(kin(14), nullptr, DM, DA, DM, (bf16*)(ws + WS_WB), 0, 0, SCR_, F.lane, (cgw + CNGW / 4) % CNGW, CNGW);
                conv_mat(kin(15), nullptr, DM, DM, DM, (bf16*)(ws + WS_WO), 0, 0, SCR_, F.lane, (cgw + CNGW / 2) % CNGW, CNGW);
                conv_w13(kin(17), kin(18), nullptr, ws, SCR_, F.lane, cgw, CNGW);
                conv_w2(kin(19), ws, SCR_, F.lane, (cgw + CNGW / 3) % CNGW, CNGW);
            }
        } else {
            for (int s = bid; s < NSEQ_P; s += G) hg_seq(F, ws, nullptr, out + OUT_SHP, Og, s, false, 0, 8);
            for (int s = bid; s < NSEQ_S; s += G) hg_seq(F, ws, st_h, out + OUT_SHS, Og, s, true, 0, 8);
            REFRESH();
            zb_rows(ws, kin(11), st_c, out, F.lane, GW_, NGW);
            conv_mat(kin(13), nullptr, DM, DA, DM, (bf16*)(ws + WS_WA), 0, 0, SCR_, F.lane, GW_, NGW);
            conv_mat(kin(14), nullptr, DM, DA, DM, (bf16*)(ws + WS_WB), 0, 0, SCR_, F.lane, GW_, NGW);
            conv_mat(kin(15), nullptr, DM, DM, DM, (bf16*)(ws + WS_WO), 0, 0, SCR_, F.lane, GW_, NGW);
            conv_w13(kin(17), kin(18), nullptr, ws, SCR_, F.lane, GW_, NGW);
            conv_w2(kin(19), ws, SCR_, F.lane, GW_, NGW);
        }
    }
    GRID_BAR();
    }

    if (phmask & (1u << 6)) {
#ifdef PROBE_D
    for (int rep_ = 0; rep_ < 3; ++rep_)
#endif
    {
        const float* Og = (const float*)(ws + WS_XN); const bf16* OGb = (const bf16*)(ws + WS_OG); bf16* ZA = (bf16*)(ws + WS_ZA);
        const float* gh = kin(12);
        const int hl = F.lane & 31, hw = F.lane >> 5, c0 = 16 * hl;
        f32x4 gg[4];
#pragma unroll
        for (int j = 0; j < 4; ++j) gg[j] = *(const GAS f32x4*)(gh + c0 + 4 * j);
        for (int t = 2 * GW_ + hw; t < T; t += 2 * NGW) {
            const size_t e = (size_t)t * DA + c0;
            f32x4 o[4]; v4u og[2];
#pragma unroll
            for (int j = 0; j < 4; ++j) o[j] = NTL((const GAS f32x4*)(Og + e + 4 * j));
            og[0] = NTL((const GAS v4u*)(OGb + e)); og[1] = NTL((const GAS v4u*)(OGb + e + 8));
            float ss = 0.f;
#pragma unroll
            for (int j = 0; j < 4; ++j) ss += (o[j].x * o[j].x + o[j].y * o[j].y) + (o[j].z * o[j].z + o[j].w * o[j].w);
            ss += __shfl_xor(ss, 1); ss += __shfl_xor(ss, 2); ss += __shfl_xor(ss, 4);
            const float rstd = 1.f / sqrtf(ss * (1.f / 128.f) + EPS);
#pragma unroll
            for (int h = 0; h < 2; ++h) { const f32x4 a = o[2 * h] * rstd * gg[2 * h], b = o[2 * h + 1] * rstd * gg[2 * h + 1]; const v4u g8 = og[h];
                v4u za; za.x = pk2(a.x * bflo(g8.x), a.y * bfhi(g8.x)); za.y = pk2(a.z * bflo(g8.y), a.w * bfhi(g8.y)); za.z = pk2(b.x * bflo(g8.z), b.y * bfhi(g8.z)); za.w = pk2(b.z * bflo(g8.w), b.w * bfhi(g8.w));
                *(GAS v4u*)(ZA + e + 8 * h) = za; }
        }
    }
    GRID_BAR();
    }

    if (phmask & (1u << 7)) {
    { pg8::Gemm g{(const bf16*)(ws + WS_ZA), (const bf16*)(ws + WS_WA), TP, DM, DA}; pg8::StaticOrder S; S.init(TP, DM, F.G, (int)blockIdx.x);
      pg8::EpiGate<0> E{(const bf16*)(ws + WS_SGA), (bf16*)(ws + WS_MG)}; pg8::gemm_phase<pg8::EpiGate<0>, pg8::StaticOrder, false, true>(F.lds, g, S, E);
    }
    VM_WAIT();
    { pg8::Gemm g{(const bf16*)(ws + WS_BG), (const bf16*)(ws + WS_WB), TP, DM, DA}; pg8::StaticOrder S; S.init(TP, DM, F.G, (int)blockIdx.x);
      pg8::EpiGate<1> E{(const bf16*)(ws + WS_SGB), (bf16*)(ws + WS_MG)}; pg8::gemm_phase<pg8::EpiGate<1>, pg8::StaticOrder, false, true>(F.lds, g, S, E);
      small_gemm_dual(F, (const bf16*)(ws + WS_ZA), (const bf16*)(ws + WS_WA), (const bf16*)(ws + WS_BG), (const bf16*)(ws + WS_WB), (const bf16*)(ws + WS_SGA), (const bf16*)(ws + WS_SGB), (bf16*)(ws + WS_MG), TP); }
    GRID_BAR();
    }

    if (phmask & (1u << 8)) {
    { pg8::Gemm g{(const bf16*)(ws + WS_MG), (const bf16*)(ws + WS_WO), TP, DM, DM}; pg8::StaticOrder S; S.init(TP, DM, F.G, (int)blockIdx.x);
      pg8::EpiRes<false> E{out, out + (size_t)TP * DM, out, XN, PARTP_, PARTS_, F.lds, kin(16)}; pg8::gemm_phase<pg8::EpiRes<false>, pg8::StaticOrder, true, true>(F.lds, g, S, E);
      small_gemm(F, (const bf16*)(ws + WS_MG), (const bf16*)(ws + WS_WO), TP, DM, pg8::EpiRes<false>{out, out + (size_t)TP * DM, out, XN, PARTP_, PARTS_, F.lds, kin(16)}); }
    GRID_BAR();
    }

    if (phmask & (1u << 9)) {
    rstd_prefetch(F, PARTP_, PARTS_);
    { pg8::Gemm g{XN, (const bf16*)(ws + WS_W13), T, 2 * DFF, DM}; pg8::StaticOrder S; S.init(T, 2 * DFF, F.G, (int)blockIdx.x);
      pg8::EpiSwiglu E{Hb, DFF, PARTP_, PARTS_, F.lds}; pg8::gemm_phase<pg8::EpiSwiglu, pg8::StaticOrder, true, true>(F.lds, g, S, E); }
    GRID_BAR();
    { pg8::Gemm g{Hb, (const bf16*)(ws + WS_W2), TP, DM, DFF}; pg8::StaticOrder S; S.init(TP, DM, F.G, (int)blockIdx.x);
      pg8::EpiRes<true> E{out, out + (size_t)TP * DM, out, nullptr, nullptr, nullptr, F.lds, nullptr}; pg8::gemm_phase<pg8::EpiRes<true>, pg8::StaticOrder, true, true>(F.lds, g, S, E);
      small_gemm(F, Hb, (const bf16*)(ws + WS_W2), TP, DFF, pg8::EpiRes<true>{out, out + (size_t)TP * DM, out, nullptr, nullptr, nullptr, F.lds, nullptr}); }
    GRID_BAR();
    }

    if (phmask & (1u << 10)) {
    { const float* gg_ = kin(20); for (int m = 2 * GW_; m < T; m += 2 * NGW) rms_row2_f32(out + (size_t)m * DM, gg_, F.lane, m + 1 < T); }
    }
#undef GW_
#undef PARTP_
#undef PARTS_
#undef SCR_
#undef IGW_
#undef REFRESH
}

extern "C" void kernel_launch(void* const* d_in, const int* in_sizes, int n_in, void* d_out, int out_size, void* d_ws, size_t ws_size, hipStream_t stream) {
    static int grid = 0;
    if (grid == 0) {
        if (n_in != 21 || in_sizes[0] != TP * DM || (size_t)out_size != OUT_END || ws_size < WS_END) { fprintf(stderr, "kernel_launch: unexpected shapes (n_in %d, in0 %d, out %d, ws %zu)\n", n_in, n_in > 0 ? in_sizes[0] : -1, out_size, ws_size); grid = -1; return; }
        int dev = 0, cus = 0, per_cu = 0;
        if (hipGetDevice(&dev) != hipSuccess || hipDeviceGetAttribute(&cus, hipDeviceAttributeMultiprocessorCount, dev) != hipSuccess) { grid = -1; return; }
        if (hipFuncSetAttribute((const void*)mk_fwd, hipFuncAttributeMaxDynamicSharedMemorySize, LDS_BYTES) != hipSuccess) { fprintf(stderr, "kernel_launch: hipFuncSetAttribute failed\n"); grid = -1; return; }
        if (hipOccupancyMaxActiveBlocksPerMultiprocessor(&per_cu, (const void*)mk_fwd, NWAVES * 64, LDS_BYTES) != hipSuccess || per_cu < 1) { fprintf(stderr, "kernel_launch: occupancy query says %d blocks per CU\n", per_cu); }
        (void)hipGetLastError();
        grid = cus;
    }
    if (grid < 0) return;
    if (hipMemsetAsync((char*)d_ws + WS_CTL, 0, CTL_ZERO_BYTES, stream) != hipSuccess) return;
    Args a{};
    for (int i = 0; i < 21; ++i) a.in[i] = (const float*)d_in[i];
    a.out = (float*)d_out; a.ws = (unsigned char*)d_ws; a.mask = 0x0000ffffu; a.pad = 0u;
    hipLaunchKernelGGL(mk_fwd, dim3(grid), dim3(NWAVES * 64), LDS_BYTES, stream, a);
#ifdef PROBE_PHASE
    (void)hipMemsetAsync((char*)d_ws + WS_CTL, 0, CTL_ZERO_BYTES, stream);
    a.mask = (PROBE_PHASE);
    hipLaunchKernelGGL(mk_fwd, dim3(grid), dim3(NWAVES * 64), LDS_BYTES, stream, a);
#endif
}
```

```cpp
#include <hip/hip_runtime.h>
#include <cstdio>
#include <cstdint>
namespace pg8 {
#define PG8_LAS __attribute__((address_space(3)))
typedef unsigned short bf16_t;
typedef short bf16x8 __attribute__((ext_vector_type(8)));
typedef float f32x4 __attribute__((ext_vector_type(4)));
typedef unsigned u32x4 __attribute__((ext_vector_type(4)));
constexpr int BM = 256, BK = 64, HALF = 128, HTB = HALF * BK * 2  , STAGE_BYTES = 8 * HTB, NXCD = 8, WGM = 8;

__host__ __device__ __forceinline__ int lds_byte(int r, int c) { const int st = (r >> 4) * 2 + (c >> 5), rr = r & 15, cc = c & 31, ob = rr * 64 + cc * 2; return st * 1024 + (ob ^ (((ob >> 9) & 1) << 5)); }
__host__ __device__ __forceinline__ void stage_rc(int b, int& R, int& C) { const int st = b / 1024, sb = b % 1024, swz = sb ^ (((sb >> 9) & 1) << 5); R = (st >> 1) * 16 + swz / 64; C = (st & 1) * 32 + (swz % 64) / 2; }
__host__ __device__ __forceinline__ int perm32(int rho) { const int n = rho >> 4, i = rho & 15; return 8 * (i >> 2) + 4 * n + (i & 3); }

struct Unit { int pm, pn; };
struct Gemm { const bf16_t* A; const bf16_t* Bt; int M, N, K; };

struct StaticOrder {
    int nM, nN, nwg, G, c;
    __host__ __device__ void init(int M, int N, int G_, int c_) { nM = M / BM; nN = N / BM; nwg = nM * nN; G = G_; c = c_; }
    __host__ __device__ bool next(int i, Unit& u) const {
        const long L = (long)i * G + c; if (L >= nwg) return false;
        int wgid = (int)L; { const int q = nwg / NXCD, r = nwg % NXCD, xcd = wgid % NXCD, off = wgid / NXCD; wgid = (xcd < r ? xcd * (q + 1) : r * (q + 1) + (xcd - r) * q) + off; }
        const int nig = WGM * nN, gid = wgid / nig, fm = gid * WGM, gsz = (nM - fm) < WGM ? (nM - fm) : WGM;
        u.pm = fm + ((wgid % nig) % gsz); u.pn = (wgid % nig) / gsz; return true;
    }
    __device__ __forceinline__ void a_ready(const Unit&) const {}
    __device__ __forceinline__ void done(const Unit&) const {}
};

__device__ __forceinline__ unsigned cvt_pk_bf16(float lo, float hi) { unsigned r; asm volatile("v_cvt_pk_bf16_f32 %0, %1, %2" : "=v"(r) : "v"(lo), "v"(hi)); return r; }

template <class Epi, class Sched, bool ALIGN_EPI = false, bool SP2 = false>
__device__ __forceinline__ void gemm_phase(PG8_LAS unsigned char* lds, const Gemm g, const Sched& S, const Epi& E) {
    const int tid = threadIdx.x, wid = __builtin_amdgcn_readfirstlane(tid >> 6), lane = tid & 63, wr = wid >> 2, wc = wid & 3, fr = lane & 15, fq = lane >> 4;
    const int K = g.K, nt = K / BK;
    unsigned voffA[2], voffB[2];
#pragma unroll
    for (int i = 0; i < 2; ++i) { int R, C; stage_rc(tid * 16 + i * 8192, R, C); const int Rb = Epi::PERM ? ((R & ~31) + perm32(R & 31)) : R;
        voffA[i] = (unsigned)(R * K + C) * 2u; voffB[i] = (unsigned)(Rb * K + C) * 2u; }
    const size_t kstep = (size_t)(BK * 2);
    const size_t hstep = (size_t)HALF * K * 2;
    const size_t tstep = 2 * hstep;
    const unsigned ldsw = (unsigned)wid * 1024u;
    const int aoff = lds_byte(wr * 64 + fr, fq * 8), boff = lds_byte(wc * 32 + fr, fq * 8);
#define PG8_SA(b, h) (((b) * 2 + (h)) * HTB)
#define PG8_SB(b, h) ((4 + (b) * 2 + (h)) * HTB)
#define PG8_STAGE(bufoff, gbase, voff) do { _Pragma("unroll") for (int _i = 0; _i < 2; ++_i) \
        __builtin_amdgcn_global_load_lds((const unsigned*)((const char*)(gbase) + (voff)[_i]), (PG8_LAS unsigned*)(lds + (bufoff) + ldsw + _i * 8192), 16, 0, 0); } while (0)
#define PG8_LDA(dst, b, h) do { _Pragma("unroll") for (int m = 0; m < 4; ++m) _Pragma("unroll") for (int k = 0; k < 2; ++k) dst[m][k] = *(const PG8_LAS bf16x8*)(lds + PG8_SA(b, h) + aoff + m * 2048 + k * 1024); } while (0)
#define PG8_LDB(dst, b, h) do { _Pragma("unroll") for (int n = 0; n < 2; ++n) _Pragma("unroll") for (int k = 0; k < 2; ++k) dst[n][k] = *(const PG8_LAS bf16x8*)(lds + PG8_SB(b, h) + boff + n * 2048 + k * 1024); } while (0)
#define PG8_MMA(ai, bj, At, Bt) do { __builtin_amdgcn_s_setprio(1); _Pragma("unroll") for (int m = 0; m < 4; ++m) _Pragma("unroll") for (int n = 0; n < 2; ++n) _Pragma("unroll") for (int k = 0; k < 2; ++k) \
        acc[ai][bj][m][n] = __builtin_amdgcn_mfma_f32_16x16x32_bf16(Bt[n][k], At[m][k], acc[ai][bj][m][n], 0, 0, 0); __builtin_amdgcn_s_setprio(0); } while (0)
#define PG8_WAIT_V(n) asm volatile("s_waitcnt vmcnt(" #n ")" ::: "memory")
#define PG8_WAIT_L(n) asm volatile("s_waitcnt lgkmcnt(" #n ")" ::: "memory")
#define PG8_BAR __builtin_amdgcn_s_barrier()
#define PG8_SCHED __builtin_amdgcn_sched_barrier(0)
    Unit cur, nxt; int ui = 0;
    if (!S.next(0, cur)) return;
    f32x4 acc[2][2][4][2];
#pragma unroll
    for (int a = 0; a < 2; ++a)
#pragma unroll
        for (int b = 0; b < 2; ++b)
#pragma unroll
            for (int m = 0; m < 4; ++m)
#pragma unroll
                for (int n = 0; n < 2; ++n) acc[a][b][m][n] = (f32x4){0.f, 0.f, 0.f, 0.f};
    bf16x8 At[4][2], B0[2][2], B1[2][2];
    const char* cA = (const char*)g.A + (size_t)cur.pm * tstep; const char* cB = (const char*)g.Bt + (size_t)cur.pn * tstep;
    S.a_ready(cur);
    if constexpr (SP2) {
        PG8_STAGE(PG8_SB(0, 0), cB, voffB); PG8_STAGE(PG8_SB(0, 1), cB + hstep, voffB); PG8_STAGE(PG8_SA(0, 0), cA, voffA); PG8_STAGE(PG8_SA(0, 1), cA + hstep, voffA);
        if (wr == 1) PG8_BAR;
        PG8_WAIT_V(2); PG8_BAR;
        PG8_STAGE(PG8_SB(1, 0), cB + kstep, voffB); PG8_STAGE(PG8_SA(1, 0), cA + kstep, voffA); PG8_STAGE(PG8_SB(1, 1), cB + hstep + kstep, voffB);
        PG8_WAIT_V(6); PG8_BAR;
    } else {
        PG8_STAGE(PG8_SB(0, 0), cB, voffB); PG8_STAGE(PG8_SA(0, 0), cA, voffA); PG8_STAGE(PG8_SB(0, 1), cB + hstep, voffB); PG8_STAGE(PG8_SA(0, 1), cA + hstep, voffA);
        if (wr == 1) PG8_BAR;
        PG8_WAIT_V(4); PG8_BAR;
        PG8_STAGE(PG8_SB(1, 0), cB + kstep, voffB); PG8_STAGE(PG8_SA(1, 0), cA + kstep, voffA); PG8_STAGE(PG8_SB(1, 1), cB + hstep + kstep, voffB);
        PG8_WAIT_V(6); PG8_BAR;
    }
    for (;;) {
        const bool has_next = S.next(ui + 1, nxt);
        const char* nA = has_next ? (const char*)g.A + (size_t)nxt.pm * tstep : cA; const char* nB = has_next ? (const char*)g.Bt + (size_t)nxt.pn * tstep : cB;
        for (int t = 0; t < nt; t += 2) {
            const bool last = (t == nt - 2);
            const char* a1 = cA + (size_t)(t + 1) * kstep;
            const char* a2 = last ? nA : cA + (size_t)(t + 2) * kstep; const char* b2 = last ? nB : cB + (size_t)(t + 2) * kstep;
            const char* a3 = a2 + kstep; const char* b3 = b2 + kstep;
            if (last && has_next) S.a_ready(nxt);
            if constexpr (SP2) {
            PG8_LDB(B0, 0, 0); PG8_LDB(B1, 0, 1); PG8_SCHED; PG8_LDA(At, 0, 0); PG8_STAGE(PG8_SA(1, 1), a1 + hstep, voffA);
            PG8_WAIT_V(8); PG8_WAIT_L(0); PG8_BAR; PG8_MMA(0, 0, At, B0); PG8_MMA(0, 1, At, B1); PG8_BAR; PG8_SCHED;
            PG8_LDA(At, 0, 1); PG8_STAGE(PG8_SB(0, 0), b2, voffB); PG8_STAGE(PG8_SB(0, 1), b2 + hstep, voffB); PG8_STAGE(PG8_SA(0, 0), a2, voffA);
            PG8_WAIT_V(8); PG8_WAIT_L(0); PG8_BAR; PG8_MMA(1, 0, At, B0); PG8_MMA(1, 1, At, B1); PG8_BAR; PG8_SCHED;
            PG8_LDB(B0, 1, 0); PG8_LDB(B1, 1, 1); PG8_SCHED; PG8_LDA(At, 1, 0); PG8_STAGE(PG8_SA(0, 1), a2 + hstep, voffA);
            PG8_WAIT_V(8); PG8_WAIT_L(0); PG8_BAR; PG8_MMA(0, 0, At, B0); PG8_MMA(0, 1, At, B1); PG8_BAR; PG8_SCHED;
            PG8_LDA(At, 1, 1); PG8_STAGE(PG8_SB(1, 0), b3, voffB); PG8_STAGE(PG8_SB(1, 1), b3 + hstep, voffB); PG8_STAGE(PG8_SA(1, 0), a3, voffA);
            PG8_WAIT_V(8); PG8_WAIT_L(0); PG8_BAR; PG8_MMA(1, 0, At, B0); PG8_MMA(1, 1, At, B1); PG8_BAR; PG8_SCHED;
            } else {
            PG8_LDB(B0, 0, 0); PG8_SCHED; PG8_LDA(At, 0, 0); PG8_STAGE(PG8_SA(1, 1), a1 + hstep, voffA);
            PG8_WAIT_L(8); PG8_BAR; PG8_WAIT_L(0); PG8_MMA(0, 0, At, B0); PG8_BAR; PG8_SCHED;
            PG8_LDB(B1, 0, 1); PG8_STAGE(PG8_SB(0, 0), b2, voffB);
            PG8_BAR; PG8_WAIT_L(0); PG8_MMA(0, 1, At, B1); PG8_BAR;
            PG8_LDA(At, 0, 1); PG8_STAGE(PG8_SA(0, 0), a2, voffA);
            PG8_BAR; PG8_WAIT_L(0); PG8_MMA(1, 0, At, B0); PG8_BAR; PG8_SCHED;
            PG8_STAGE(PG8_SB(0, 1), b2 + hstep, voffB);
            PG8_WAIT_V(6); PG8_BAR; PG8_MMA(1, 1, At, B1); PG8_BAR;
            PG8_LDB(B0, 1, 0); PG8_SCHED; PG8_LDA(At, 1, 0); PG8_STAGE(PG8_SA(0, 1), a2 + hstep, voffA);
            PG8_WAIT_L(8); PG8_BAR; PG8_WAIT_L(0); PG8_MMA(0, 0, At, B0); PG8_BAR; PG8_SCHED;
            PG8_LDB(B1, 1, 1); PG8_STAGE(PG8_SB(1, 0), b3, voffB);
            PG8_BAR; PG8_WAIT_L(0); PG8_MMA(0, 1, At, B1); PG8_BAR;
            PG8_LDA(At, 1, 1); PG8_STAGE(PG8_SA(1, 0), a3, voffA);
            PG8_BAR; PG8_WAIT_L(0); PG8_MMA(1, 0, At, B0); PG8_BAR; PG8_SCHED;
            PG8_STAGE(PG8_SB(1, 1), b3 + hstep, voffB);
            PG8_WAIT_V(6); PG8_BAR; PG8_MMA(1, 1, At, B1); PG8_BAR;
            }
        }
        if constexpr (ALIGN_EPI) { if (wr == 0) PG8_BAR; }
        if constexpr (!Epi::AFTER_DRAIN) { E(acc, cur, wr, wc, fr, fq); S.done(cur); }
        if (!has_next) break;
#pragma unroll
        for (int a = 0; a < 2; ++a)
#pragma unroll
            for (int b = 0; b < 2; ++b)
#pragma unroll
                for (int m = 0; m < 4; ++m)
#pragma unroll
                    for (int n = 0; n < 2; ++n) acc[a][b][m][n] = (f32x4){0.f, 0.f, 0.f, 0.f};
        cur = nxt; cA = nA; cB = nB; ++ui;
        if constexpr (ALIGN_EPI) { if (wr == 1) PG8_BAR; }
    }
    PG8_WAIT_V(0);
    if constexpr (!ALIGN_EPI) { if (wr == 0) PG8_BAR; }
    PG8_BAR;
    if constexpr (Epi::AFTER_DRAIN) { E.fused(acc, cur, wr, wc, fr, fq, lds, wid, lane); S.done(cur); }
#undef PG8_SA
#undef PG8_SB
#undef PG8_STAGE
#undef PG8_LDA
#undef PG8_LDB
#undef PG8_MMA
#undef PG8_WAIT_V
#undef PG8_WAIT_L
#undef PG8_BAR
#undef PG8_SCHED
}
}

constexpr int DM = 1024, DFF = 2816, DA = 512, NIN = 5632;
constexpr int TP = 16384, TS = 1024, T = TP + TS;
constexpr int NSEQ_P = 32, NSEQ_S = 512;
constexpr float EPS = 1e-6f;
constexpr int NWAVES = 8;

constexpr size_t OUT_Y = 0, OUT_SHP = (size_t)T * DM, OUT_SCP = OUT_SHP + 524288, OUT_SHS = OUT_SCP + 8192, OUT_SCS = OUT_SHS + 8388608, OUT_END = OUT_SCS + 131072;

constexpr size_t MiB = 1u << 20;
constexpr size_t WS_CTL = 0, CTL_ZERO_BYTES = 1 * MiB;
constexpr size_t WS_WIN = 1 * MiB, WS_WA = 12 * MiB, WS_WB = 13 * MiB, WS_WO = 14 * MiB;
constexpr size_t WS_W13 = 16 * MiB, WS_W2 = 27 * MiB;
constexpr size_t WS_XN = 32 * MiB + 512 * 1024;
constexpr size_t WS_ARENA = WS_XN + 34 * MiB;
constexpr size_t UNITB = (size_t)T * 512 * 2;
constexpr size_t WS_H = WS_ARENA;
constexpr size_t WS_SGA = WS_ARENA, WS_SGB = WS_ARENA + 2 * UNITB, WS_OG = WS_ARENA + 4 * UNITB, WS_BG = WS_ARENA + 5 * UNITB, WS_U = WS_ARENA + 6 * UNITB;
constexpr size_t WS_Q = WS_ARENA + 7 * UNITB, WS_V = WS_ARENA + 8 * UNITB, WS_LOGF = WS_ARENA + 9 * UNITB;
constexpr size_t WS_ZA = WS_Q, WS_ZB = WS_V, WS_MG = WS_LOGF;
constexpr size_t WS_PARTP = WS_ARENA + 11 * UNITB;
constexpr size_t WS_PARTS = WS_PARTP + (size_t)TP * 16;
constexpr size_t WS_END = WS_PARTS + (size_t)TS * 64;
static_assert(WS_END <= 256 * MiB, "ws map");
static_assert((size_t)T * DFF * 2 <= 6 * UNITB, "H fits");
constexpr int CW_BAR = 4096;

constexpr int RING_BYTES = 131072, LDSCTL_OFF = RING_BYTES, MISC_OFF = LDSCTL_OFF + 320, ROWSUM_OFF = RING_BYTES + 2048, PMT_OFF = RING_BYTES + 3072, RSL_OFF = RING_BYTES + 4096, RSL_SLOTS = 6, LDS_BYTES = 147456;

#define GAS __attribute__((address_space(1)))
#define LAS __attribute__((address_space(3)))
typedef unsigned short bf16;
typedef unsigned v4u __attribute__((ext_vector_type(4)));
typedef unsigned v2u __attribute__((ext_vector_type(2)));
typedef float f32x4 __attribute__((ext_vector_type(4)));
typedef short bf16x8 __attribute__((ext_vector_type(8)));
typedef GAS unsigned gu32;
#define NTL(p) (*(p))
#define LDS_WAIT() asm volatile("s_waitcnt lgkmcnt(0)" ::: "memory")
#define VM_WAIT() asm volatile("s_waitcnt vmcnt(0)" ::: "memory")
#define LDSBAR() do { asm volatile("s_waitcnt lgkmcnt(0)" ::: "memory"); __builtin_amdgcn_s_barrier(); asm volatile("" ::: "memory"); } while (0)
__device__ __forceinline__ unsigned f2bf(float f) { unsigned u = __builtin_bit_cast(unsigned, f); return (u + 0x7fffu + ((u >> 16) & 1u)) >> 16; }
typedef float f32x2_t_ __attribute__((ext_vector_type(2)));
typedef __bf16 bf16x2_t_ __attribute__((ext_vector_type(2)));
__device__ __forceinline__ unsigned pk2(float lo, float hi) { const f32x2_t_ v = {lo, hi}; return __builtin_bit_cast(unsigned, __builtin_convertvector(v, bf16x2_t_)); }
__device__ __forceinline__ float bf2f(unsigned short h) { return __builtin_bit_cast(float, (unsigned)h << 16); }
__device__ __forceinline__ float bflo(unsigned w) { return __builtin_bit_cast(float, w << 16); }
__device__ __forceinline__ float bfhi(unsigned w) { return __builtin_bit_cast(float, w & 0xffff0000u); }
__device__ __forceinline__ float sigmoidf_(float x) { return __builtin_amdgcn_rcpf(1.0f + __expf(-x)); }
__device__ __forceinline__ float siluf_(float x) { return x * sigmoidf_(x); }

#define XB_TMO      128
#define XB_XCNT(j)  (256  + 64 * (j))
#define XB_XSUB(j)  (1280 + 64 * (j))
#define XB_XGEN(j)  (2304 + 64 * (j))
#define XB_TOP      3328
#define XB_TOPGEN   3392
#define XCD_BAR_WORDS 3456
#define XB_SPIN_CAP (1u << 18)

__device__ __forceinline__ unsigned xb_ld(unsigned* p)              { return __hip_atomic_load(p, __ATOMIC_RELAXED, __HIP_MEMORY_SCOPE_AGENT); }
__device__ __forceinline__ unsigned xb_add(unsigned* p, unsigned v) { return __hip_atomic_fetch_add(p, v, __ATOMIC_RELAXED, __HIP_MEMORY_SCOPE_AGENT); }
__device__ __forceinline__ unsigned xb_xcc_id() { return (unsigned)__builtin_amdgcn_s_getreg((3 << 11) | 20) & 0xFu; }
#define XB_SPIN(cond, bar) do { unsigned _sp = 0; while (cond) { __builtin_amdgcn_s_sleep(1); \
    if ((++_sp & 255u) == 0u) { if (xb_ld(&(bar)[XB_TMO])) break; if (_sp > XB_SPIN_CAP) { atomicAdd(&(bar)[XB_TMO], 1u); break; } } } } while (0)

struct XcdBarrier {
    unsigned* bar; unsigned x;
    volatile LAS unsigned* st;
};

__device__ __forceinline__ XcdBarrier xcd_barrier_post(unsigned* bar, volatile LAS unsigned* st) {
    XcdBarrier b; b.bar = bar; b.x = xb_xcc_id(); b.st = st;
    if (threadIdx.x == 0) (void)xb_add(&bar[XB_XCNT(b.x)], 1u);
    return b;
}
__device__ __forceinline__ void xcd_barrier_complete(unsigned* bar, unsigned x, unsigned& nloc, unsigned& nx) {
    const unsigned G = gridDim.x * gridDim.y * gridDim.z;
    unsigned sum, cnt, mine, sp = 0u;
    for (;;) {
        sum = 0u; cnt = 0u; mine = 0u;
#pragma unroll
        for (unsigned j = 0; j < 16; ++j) { const unsigned c = xb_ld(&bar[XB_XCNT(j)]); sum += c; cnt += (c > 0u) ? 1u : 0u; mine = (j == x) ? c : mine; }
        if (sum == G) break;
        __builtin_amdgcn_s_sleep(1);
        if ((++sp & 255u) == 0u) { if (xb_ld(&bar[XB_TMO])) break; if (sp > XB_SPIN_CAP) { atomicAdd(&bar[XB_TMO], 1u); break; } }
    }
    nloc = mine > 0u ? mine : 1u; nx = cnt > 0u ? cnt : 1u;
}

__device__ __forceinline__ void xcd_barrier(const XcdBarrier& b) {
    asm volatile("s_waitcnt vmcnt(0)" ::: "memory");
    __syncthreads();
    if (threadIdx.x == 0) {
        unsigned* bar = b.bar;
        __builtin_amdgcn_s_waitcnt(0);
        unsigned nloc = b.st[0], nx = b.st[1];
        if (nloc == 0u) { xcd_barrier_complete(bar, b.x, nloc, nx); b.st[0] = nloc; b.st[1] = nx; }
        const unsigned old = xb_add(&bar[XB_XSUB(b.x)], 1u);
        const unsigned gen = old / nloc;
        if (old + 1u == (gen + 1u) * nloc) {
            __builtin_amdgcn_fence(__ATOMIC_RELEASE, "agent");
            asm volatile("s_waitcnt vmcnt(0)" ::: "memory");
            const unsigned og = xb_add(&bar[XB_TOP], 1u);
            const unsigned tg = og / nx;
            if (og + 1u == (tg + 1u) * nx) xb_add(&bar[XB_TOPGEN], 1u);
            else XB_SPIN(xb_ld(&bar[XB_TOPGEN]) == tg, bar);
            __builtin_amdgcn_fence(__ATOMIC_ACQUIRE, "agent");
            xb_add(&bar[XB_XGEN(b.x)], 1u);
            asm volatile("s_waitcnt vmcnt(0)" ::: "memory");
        } else {
            XB_SPIN(xb_ld(&bar[XB_XGEN(b.x)]) == gen, bar);
            __builtin_amdgcn_fence(__ATOMIC_ACQUIRE, "agent");
            asm volatile("s_waitcnt vmcnt(0)" ::: "memory");
        }
    }
    __syncthreads();
}


#if defined(PROBE_E2) || defined(PROBE_E3) || defined(PROBE_E4) || defined(PROBE_E5)
__device__ __forceinline__ void xcd_barrier_probe(const XcdBarrier& b) {
    asm volatile("s_waitcnt vmcnt(0)" ::: "memory");
    __syncthreads();
    if (threadIdx.x == 0) {
        unsigned* bar = b.bar;
        unsigned nloc = b.st[0], nx = b.st[1];
        const unsigned old = xb_add(&bar[XB_XSUB(b.x)], 1u);
        const unsigned gen = old / nloc;
        if (old + 1u == (gen + 1u) * nloc) {
#if !defined(PROBE_E3) && !defined(PROBE_E4)
            __builtin_amdgcn_fence(__ATOMIC_RELEASE, "agent");
#endif
            asm volatile("s_waitcnt vmcnt(0)" ::: "memory");
            const unsigned og = xb_add(&bar[XB_TOP], 1u);
            const unsigned tg = og / nx;
            if (og + 1u == (tg + 1u) * nx) xb_add(&bar[XB_TOPGEN], 1u);
            else XB_SPIN(xb_ld(&bar[XB_TOPGEN]) == tg, bar);
#if !defined(PROBE_E2) && !defined(PROBE_E4)
            __builtin_amdgcn_fence(__ATOMIC_ACQUIRE, "agent");
#endif
            xb_add(&bar[XB_XGEN(b.x)], 1u);
            asm volatile("s_waitcnt vmcnt(0)" ::: "memory");
        } else {
            XB_SPIN(xb_ld(&bar[XB_XGEN(b.x)]) == gen, bar);
#if !defined(PROBE_E2) && !defined(PROBE_E4) && !defined(PROBE_E5)
            __builtin_amdgcn_fence(__ATOMIC_ACQUIRE, "agent");
#endif
            asm volatile("s_waitcnt vmcnt(0)" ::: "memory");
        }
    }
    __syncthreads();
}
#endif

namespace pg8 {
static_assert(RSL_OFF + RSL_SLOTS * 1024 <= LDS_BYTES, "rstd slots inside the LDS allocation");
__device__ __forceinline__ float row_rstd(const float* PP, const float* PS, int row) {
    float ss;
    if (row < TP) { const f32x4 a = NTL((const f32x4*)(PP + (size_t)row * 4)); ss = (a[0] + a[1]) + (a[2] + a[3]); }
    else { const f32x4* p = (const f32x4*)(PS + (size_t)(row - TP) * 16); const f32x4 a = (NTL(p) + NTL(p + 1)) + (NTL(p + 2) + NTL(p + 3)); ss = (a[0] + a[1]) + (a[2] + a[3]); }
    return 1.0f / sqrtf(ss * (1.0f / DM) + EPS);
}
__device__ __forceinline__ int rstd_slot(PG8_LAS unsigned char* ldsb, int pm) {
    const PG8_LAS int* PMT = (const PG8_LAS int*)(ldsb + PMT_OFF); int slot = -1;
#pragma unroll
    for (int i = 0; i < RSL_SLOTS; ++i) if (PMT[i] == pm) slot = i;
    return slot;
}
struct EpiSwiglu {
    static constexpr bool PERM = false, AFTER_DRAIN = false;
    bf16_t* H; int ldh; const float* PP; const float* PS; PG8_LAS unsigned char* ldsb;
    __device__ __forceinline__ void operator()(const f32x4 (&acc)[2][2][4][2], const Unit& u, int wr, int wc, int fr, int fq) const {
        const int row0 = u.pm * BM + wr * 64 + fr, hid0 = u.pn * 128 + wc * 16 + 4 * fq;
        float rs[2][4];
#pragma unroll
        for (int ai = 0; ai < 2; ++ai)
#pragma unroll
            for (int m = 0; m < 4; ++m) rs[ai][m] = 1.0f;
        if (PP) { const int slot = rstd_slot(ldsb, u.pm); const PG8_LAS float* RSL = (const PG8_LAS float*)(ldsb + RSL_OFF) + (slot < 0 ? 0 : slot) * 256 + wr * 64 + fr;
#pragma unroll
            for (int ai = 0; ai < 2; ++ai)
#pragma unroll
                for (int m = 0; m < 4; ++m) rs[ai][m] = slot >= 0 ? RSL[ai * HALF + m * 16] : row_rstd(PP, PS, row0 + ai * HALF + m * 16); }
#pragma unroll
        for (int ai = 0; ai < 2; ++ai)
#pragma unroll
            for (int m = 0; m < 4; ++m) { bf16_t* rowp = H + (size_t)(row0 + ai * HALF + m * 16) * ldh + hid0;
#pragma unroll
                for (int bj = 0; bj < 2; ++bj) { const f32x4 a = acc[ai][bj][m][0] * rs[ai][m], b = acc[ai][bj][m][1] * rs[ai][m];
                    v2u w; w.x = pk2(siluf_(a[0]) * b[0], siluf_(a[1]) * b[1]); w.y = pk2(siluf_(a[2]) * b[2], siluf_(a[3]) * b[3]);
                    *(v2u*)(rowp + bj * 64) = w; } }
    }
};
template <bool HALF_ALPHA> struct EpiRes {
    static constexpr bool PERM = false, AFTER_DRAIN = false;
    static constexpr float alpha = HALF_ALPHA ? 0.5f : 1.0f;
    const float* srcP; const float* srcS; float* out; bf16_t* XNo; float* PP; float* PS; PG8_LAS unsigned char* ldsb; const float* gain;
    __device__ __forceinline__ bool has_norm() const { return XNo != nullptr; }
    __device__ __forceinline__ float store4(int row, int col, f32x4 a) const {
        const float* sb = (row < TP) ? srcP : srcS - (size_t)TP * DM; const size_t o = (size_t)row * DM + col;
        const f32x4 s = NTL((const f32x4*)(sb + o)); const f32x4 v = s + a * alpha; *(f32x4*)(out + o) = v;
        if (XNo) { const f32x4 gg = *(const f32x4*)(gain + col); v2u w; w.x = pk2(v[0] * gg[0], v[1] * gg[1]); w.y = pk2(v[2] * gg[2], v[3] * gg[3]); *(v2u*)(XNo + o) = w; return (v[0] * v[0] + v[1] * v[1]) + (v[2] * v[2] + v[3] * v[3]); }
        return 0.f;
    }
    __device__ __forceinline__ void row_store_s(int row, int slot, float ss) const { PS[(size_t)(row - TP) * 16 + slot] = ss; }
    struct Pre { f32x4 s; };
    __device__ __forceinline__ Pre pre4(int row, int col) const { const float* sb = (row < TP) ? srcP : srcS - (size_t)TP * DM; Pre p; p.s = NTL((const f32x4*)(sb + (size_t)row * DM + col)); return p; }
    __device__ __forceinline__ float store4pg(int row, int col, f32x4 a, const Pre& p, f32x4 gg) const {
        const size_t o = (size_t)row * DM + col; const f32x4 v = p.s + a * alpha; *(f32x4*)(out + o) = v;
        if (XNo) { v2u w; w.x = pk2(v[0] * gg[0], v[1] * gg[1]); w.y = pk2(v[2] * gg[2], v[3] * gg[3]); *(v2u*)(XNo + o) = w; return (v[0] * v[0] + v[1] * v[1]) + (v[2] * v[2] + v[3] * v[3]); }
        return 0.f;
    }
    __device__ __forceinline__ float store4p(int row, int col, f32x4 a, const Pre& p) const {
        const size_t o = (size_t)row * DM + col; const f32x4 v = p.s + a * alpha; *(f32x4*)(out + o) = v;
        if (XNo) { const f32x4 gg = *(const f32x4*)(gain + col); v2u w; w.x = pk2(v[0] * gg[0], v[1] * gg[1]); w.y = pk2(v[2] * gg[2], v[3] * gg[3]); *(v2u*)(XNo + o) = w; return (v[0] * v[0] + v[1] * v[1]) + (v[2] * v[2] + v[3] * v[3]); }
        return 0.f;
    }
    __device__ __forceinline__ void operator()(const f32x4 (&acc)[2][2][4][2], const Unit& u, int wr, int wc, int fr, int fq) const {
        const int row0 = u.pm * BM + wr * 64 + fr, col0 = u.pn * BM + wc * 32 + 4 * fq;
        PG8_LAS float* ROWSUM = (PG8_LAS float*)(ldsb + ROWSUM_OFF);
        const bool norm = has_norm();
        if (norm) { if (threadIdx.x < 256) ROWSUM[threadIdx.x] = 0.f; asm volatile("s_waitcnt lgkmcnt(0)" ::: "memory"); __builtin_amdgcn_s_barrier(); asm volatile("" ::: "memory"); }
        f32x4 gg[2][2];
#pragma unroll
        for (int bj = 0; bj < 2; ++bj)
#pragma unroll
            for (int n = 0; n < 2; ++n) gg[bj][n] = norm ? *(const f32x4*)(gain + col0 + bj * HALF + n * 16) : (f32x4){0.f, 0.f, 0.f, 0.f};
#pragma unroll
        for (int am = 0; am < 4; ++am) {
            const int ai = am >> 1, mb = (am & 1) * 2;
            Pre pv[2][2][2];
#pragma unroll
            for (int mm = 0; mm < 2; ++mm)
#pragma unroll
                for (int bj = 0; bj < 2; ++bj)
#pragma unroll
                    for (int n = 0; n < 2; ++n) pv[mm][bj][n] = pre4(row0 + ai * HALF + (mb + mm) * 16, col0 + bj * HALF + n * 16);
#pragma unroll
            for (int mm = 0; mm < 2; ++mm) { const int m = mb + mm; float ss = 0.f;
#pragma unroll
                for (int bj = 0; bj < 2; ++bj)
#pragma unroll
                    for (int n = 0; n < 2; ++n) ss += store4pg(row0 + ai * HALF + m * 16, col0 + bj * HALF + n * 16, acc[ai][bj][m][n], pv[mm][bj][n], gg[bj][n]);
                if (norm) { ss += __shfl_xor(ss, 16); ss += __shfl_xor(ss, 32); if (fq == 0) (void)__hip_atomic_fetch_add(ROWSUM + ai * HALF + wr * 64 + m * 16 + fr, ss, __ATOMIC_RELAXED, __HIP_MEMORY_SCOPE_WORKGROUP); } }
        }
        if (norm) { asm volatile("s_waitcnt lgkmcnt(0)" ::: "memory"); __builtin_amdgcn_s_barrier(); asm volatile("" ::: "memory");
            if (threadIdx.x < 256) PP[(size_t)(u.pm * BM + threadIdx.x) * 4 + u.pn] = ROWSUM[threadIdx.x]; }
    }
};
template <int MODE> struct EpiGate {
    static constexpr bool PERM = false, AFTER_DRAIN = false;
    const bf16_t* SG; bf16_t* MG;
    __device__ __forceinline__ bool has_norm() const { return false; }
    __device__ __forceinline__ void row_store_s(int, int, float) const {}
    struct Pre { v2u g, m; };
    __device__ __forceinline__ Pre pre4(int row, int col) const { const size_t o = (size_t)row * DM + col; Pre p; p.g = NTL((const v2u*)(SG + o)); p.m = (v2u){0u, 0u}; if (MODE == 1) p.m = NTL((const v2u*)(MG + o)); return p; }
    __device__ __forceinline__ float store4p(int row, int col, f32x4 a, const Pre& p) const {
        const size_t o = (size_t)row * DM + col;
        float r0 = bflo(p.g.x) * a[0], r1 = bfhi(p.g.x) * a[1], r2 = bflo(p.g.y) * a[2], r3 = bfhi(p.g.y) * a[3];
        if (MODE == 1) { r0 += bflo(p.m.x); r1 += bfhi(p.m.x); r2 += bflo(p.m.y); r3 += bfhi(p.m.y); }
        v2u w; w.x = pk2(r0, r1); w.y = pk2(r2, r3); *(v2u*)(MG + o) = w; return 0.f;
    }
    __device__ __forceinline__ float store4(int row, int col, f32x4 a) const {
        const size_t o = (size_t)row * DM + col; const v2u g = NTL((const v2u*)(SG + o));
        float r0 = bflo(g.x) * a[0], r1 = bfhi(g.x) * a[1], r2 = bflo(g.y) * a[2], r3 = bfhi(g.y) * a[3];
        if (MODE == 1) { const v2u p = NTL((const v2u*)(MG + o)); r0 += bflo(p.x); r1 += bfhi(p.x); r2 += bflo(p.y); r3 += bfhi(p.y); }
        v2u w; w.x = pk2(r0, r1); w.y = pk2(r2, r3); *(v2u*)(MG + o) = w; return 0.f;
    }
    __device__ __forceinline__ void operator()(const f32x4 (&acc)[2][2][4][2], const Unit& u, int wr, int wc, int fr, int fq) const {
        const int row0 = u.pm * BM + wr * 64 + fr, col0 = u.pn * BM + wc * 32 + 4 * fq;
#pragma unroll
        for (int am = 0; am < 4; ++am) {
            const int ai = am >> 1, mb = (am & 1) * 2;
            Pre pv[2][2][2];
#pragma unroll
            for (int mm = 0; mm < 2; ++mm)
#pragma unroll
                for (int bj = 0; bj < 2; ++bj)
#pragma unroll
                    for (int n = 0; n < 2; ++n) pv[mm][bj][n] = pre4(row0 + ai * HALF + (mb + mm) * 16, col0 + bj * HALF + n * 16);
#pragma unroll
            for (int mm = 0; mm < 2; ++mm)
#pragma unroll
                for (int bj = 0; bj < 2; ++bj)
#pragma unroll
                    for (int n = 0; n < 2; ++n) (void)store4p(row0 + ai * HALF + (mb + mm) * 16, col0 + bj * HALF + n * 16, acc[ai][bj][mb + mm][n], pv[mm][bj][n]);
        }
    }
};
struct EpiMix {
    static constexpr bool PERM = false, AFTER_DRAIN = false;
    bf16_t *Q, *V, *OG, *BG, *U, *SGA, *SGB; float* LOGF; const float* lbl; const float* PP; const float* PS; PG8_LAS unsigned char* ldsb;
    __device__ __forceinline__ void operator()(const f32x4 (&acc_)[2][2][4][2], const Unit& u, int wr, int wc, int fr, int fq) const {
        const int pn = u.pn, row0 = u.pm * BM + wr * 64 + fr;
        f32x4 acc[2][2][4][2];
        { float rs[2][4]; const int slot_ = rstd_slot(ldsb, u.pm); const PG8_LAS float* RSL_ = (const PG8_LAS float*)(ldsb + RSL_OFF) + (slot_ < 0 ? 0 : slot_) * 256 + wr * 64 + fr;
#pragma unroll
          for (int ai = 0; ai < 2; ++ai)
#pragma unroll
              for (int m = 0; m < 4; ++m) { rs[ai][m] = slot_ >= 0 ? RSL_[ai * HALF + m * 16] : row_rstd(PP, PS, row0 + ai * HALF + m * 16); }
#pragma unroll
          for (int ai = 0; ai < 2; ++ai)
#pragma unroll
              for (int m = 0; m < 4; ++m)
#pragma unroll
                  for (int bj = 0; bj < 2; ++bj)
#pragma unroll
                      for (int n = 0; n < 2; ++n) acc[ai][bj][m][n] = acc_[ai][bj][m][n] * rs[ai][m]; }
        if (pn >= 10 && pn < 14) {
            const int ch0 = (pn - 10) * 128 + wc * 16 + 4 * fq;
#pragma unroll
            for (int ai = 0; ai < 2; ++ai)
#pragma unroll
                for (int m = 0; m < 4; ++m) { bf16_t* rowp = U + (size_t)(row0 + ai * HALF + m * 16) * DA + ch0;
#pragma unroll
                    for (int bj = 0; bj < 2; ++bj) { const f32x4 a = acc[ai][bj][m][0], b = acc[ai][bj][m][1];
                        v2u w; w.x = pk2(a[0] * b[0], a[1] * b[1]); w.y = pk2(a[2] * b[2], a[3] * b[3]); *(v2u*)(rowp + bj * 64) = w; } }
            return;
        }
        const int colt = wc * 32 + 4 * fq;
        if (pn == 2 || pn == 3) {
            const int c0 = (pn - 2) * 256 + colt;
#pragma unroll
            for (int bj = 0; bj < 2; ++bj)
#pragma unroll
                for (int n = 0; n < 2; ++n) { const int c = c0 + bj * HALF + n * 16;
                    const f32x4 l0 = *(const f32x4*)(lbl + c), l1 = *(const f32x4*)(lbl + 512 + c); f32x4 lb;
#pragma unroll
                    for (int i = 0; i < 4; ++i) lb[i] = sigmoidf_(l0[i] - l1[i]);
#pragma unroll
                    for (int ai = 0; ai < 2; ++ai)
#pragma unroll
                        for (int m = 0; m < 4; ++m) { const f32x4 z = acc[ai][bj][m][n]; f32x4 o;
#pragma unroll
                            for (int i = 0; i < 4; ++i) o[i] = __logf(lb[i] + (1.0f - lb[i]) * sigmoidf_(z[i]));
                            *(f32x4*)(LOGF + (size_t)(row0 + ai * HALF + m * 16) * DA + c) = o; } }
            return;
        }
        bf16_t* base; int ld, c0, act;
        if (pn < 2) { base = Q; ld = DA; c0 = pn * 256; act = 0; }
        else if (pn < 6) { base = V; ld = DA; c0 = (pn - 4) * 256; act = 0; }
        else if (pn < 8) { base = OG; ld = DA; c0 = (pn - 6) * 256; act = 1; }
        else if (pn < 10) { base = BG; ld = DA; c0 = (pn - 8) * 256; act = 0; }
        else if (pn < 18) { base = SGA; ld = DM; c0 = (pn - 14) * 256; act = 2; }
        else { base = SGB; ld = DM; c0 = (pn - 18) * 256; act = 2; }
        c0 += colt;
#pragma unroll
        for (int ai = 0; ai < 2; ++ai)
#pragma unroll
            for (int m = 0; m < 4; ++m) { bf16_t* rowp = base + (size_t)(row0 + ai * HALF + m * 16) * ld + c0;
#pragma unroll
                for (int bj = 0; bj < 2; ++bj)
#pragma unroll
                    for (int n = 0; n < 2; ++n) { f32x4 a = acc[ai][bj][m][n];
                        if (act == 1) { a[0] = siluf_(a[0]); a[1] = siluf_(a[1]); a[2] = siluf_(a[2]); a[3] = siluf_(a[3]); }
                        else if (act == 2) { a[0] = sigmoidf_(a[0]); a[1] = sigmoidf_(a[1]); a[2] = sigmoidf_(a[2]); a[3] = sigmoidf_(a[3]); }
                        v2u w; w.x = pk2(a[0], a[1]); w.y = pk2(a[2], a[3]); *(v2u*)(rowp + bj * HALF + n * 16) = w; } }
    }
};
}

struct Frame {
    LAS unsigned char* lds;
    volatile LAS unsigned* MISC;
    gu32* ctl;
    int tid, lane, wave, vcu, G;
};
struct Args { const float* in[21]; float* out; unsigned char* ws; unsigned mask; unsigned pad; };
typedef const __attribute__((address_space(4))) Args* KArgs;
__device__ __forceinline__ const float* kin(int k) { KArgs p = (KArgs)__builtin_amdgcn_kernarg_segment_ptr(); asm volatile("" : "+s"(p)); return p->in[k]; }

__device__ __forceinline__ float wave_sum(float v) {
#pragma unroll
    for (int o = 1; o < 64; o <<= 1) v += __shfl_xor(v, o);
    return v;
}
__device__ __forceinline__ void transpose_item(const float* W, const float* g, int ldw, int K, int ncols, bf16* WT, int mode, int roff, LAS float* scr, int item, int lane) {
    const int nblk = ncols / 32, kb = item / nblk, nb = item % nblk, k0 = 64 * kb, n0 = 32 * nb;
    const float g0 = g ? g[k0 + lane] : 1.0f;
#pragma unroll 8
    for (int i = 0; i < 32; ++i) { const int kk = 2 * i + (lane >> 5); scr[kk * 33 + (lane & 31)] = W[(size_t)(k0 + kk) * ldw + n0 + (lane & 31)] * __shfl(g0, kk); }
    LDS_WAIT(); asm volatile("" ::: "memory");
    const int c = lane & 7;
#pragma unroll
    for (int j = 0; j < 4; ++j) { const int n = (lane >> 3) + 8 * j; const LAS float* s = scr + (8 * c) * 33 + n;
        v4u o; o.x = pk2(s[0 * 33], s[1 * 33]); o.y = pk2(s[2 * 33], s[3 * 33]); o.z = pk2(s[4 * 33], s[5 * 33]); o.w = pk2(s[6 * 33], s[7 * 33]);
        const int jc = n0 + n; const int drow = mode ? roff + ((jc >> 4) << 5) + (jc & 15) : roff + jc;
        *(GAS v4u*)(WT + (size_t)drow * K + k0 + 8 * c) = o; }
    LDS_WAIT(); asm volatile("" ::: "memory");
}
__device__ __forceinline__ void conv_mat(const float* W, const float* g, int ldw, int K, int ncols, bf16* WT, int mode, int roff, LAS float* scr, int lane, int gw, int NGW) {
    const int nitems = (K / 64) * (ncols / 32);
    for (int it = gw; it < nitems; it += NGW) transpose_item(W, g, ldw, K, ncols, WT, mode, roff, scr, it, lane);
}
__device__ __forceinline__ void conv_w13(const float* w1, const float* w3, const float* g, unsigned char* ws, LAS float* scr, int lane, int gw, int NGW) {
    bf16* W13 = (bf16*)(ws + WS_W13);
    conv_mat(w1, g, DFF, DM, DFF, W13, 1, 0, scr, lane, gw, NGW);
    conv_mat(w3, g, DFF, DM, DFF, W13, 1, 16, scr, lane, (gw + NGW / 2) % NGW, NGW);
}
__device__ __forceinline__ void conv_w2(const float* w2, unsigned char* ws, LAS float* scr, int lane, int gw, int NGW) {
    conv_mat(w2, nullptr, DM, DFF, DM, (bf16*)(ws + WS_W2), 0, 0, scr, lane, gw, NGW);
}
__device__ __forceinline__ void rms_row2_bf16(const float* xrowA, const float* xrowB, const float* g, bf16* orowA, bf16* orowB, int lane) {
    const int hl = lane & 31, hw = lane >> 5;
    const GAS f32x4* xr = (const GAS f32x4*)(hw ? xrowB : xrowA) + hl; const GAS f32x4* gr = (const GAS f32x4*)g + hl;
    f32x4 v[8]; float s = 0.f;
#pragma unroll
    for (int j = 0; j < 8; ++j) { v[j] = xr[32 * j]; s += (v[j].x * v[j].x + v[j].y * v[j].y) + (v[j].z * v[j].z + v[j].w * v[j].w); }
#pragma unroll
    for (int o = 1; o < 32; o <<= 1) s += __shfl_xor(s, o);
    const float rstd = 1.f / sqrtf(s * (1.f / DM) + EPS);
    GAS v2u* o8 = (GAS v2u*)(hw ? orowB : orowA) + hl;
#pragma unroll
    for (int j = 0; j < 8; ++j) { const f32x4 gg = gr[32 * j]; v2u w; w.x = pk2(v[j].x * rstd * gg.x, v[j].y * rstd * gg.y); w.y = pk2(v[j].z * rstd * gg.z, v[j].w * rstd * gg.w); o8[32 * j] = w; }
}
__device__ __forceinline__ void rms_row2_f32(float* xrow0, const float* g, int lane, bool second_valid) {
    const int hl = lane & 31, hw = lane >> 5;
    if (hw && !second_valid) return;
    GAS f32x4* xr = (GAS f32x4*)(xrow0 + (size_t)hw * DM) + hl; const GAS f32x4* gr = (const GAS f32x4*)g + hl;
    f32x4 v[8]; float s = 0.f;
#pragma unroll
    for (int j = 0; j < 8; ++j) { v[j] = NTL(xr + 32 * j); s += (v[j].x * v[j].x + v[j].y * v[j].y) + (v[j].z * v[j].z + v[j].w * v[j].w); }
#pragma unroll
    for (int o = 1; o < 32; o <<= 1) s += __shfl_xor(s, o);
    const float rstd = 1.f / sqrtf(s * (1.f / DM) + EPS);
#pragma unroll
    for (int j = 0; j < 8; ++j) { const f32x4 gg = gr[32 * j]; xr[32 * j] = v[j] * rstd * gg; }
}

__device__ __forceinline__ void hg_prep(const Frame& F, unsigned char* ws, unsigned char* sfr) {
    LAS unsigned char* L = F.lds;
    LAS float* LB = (LAS float*)L;
    LAS bf16* QD = (LAS bf16*)(L + 16896);
    LAS bf16* KD = (LAS bf16*)(L + 16896 + 8704);
    LAS bf16* KET = (LAS bf16*)(L + 16896 + 2 * 8704);
    LAS bf16* VT = (LAS bf16*)(L + 16896 + 2 * 8704 + 10240);
    LAS bf16* SC = (LAS bf16*)(L + 16896 + 2 * 8704 + 2 * 10240);
    const bf16* Qg = (const bf16*)(ws + WS_Q); const bf16* Vg = (const bf16*)(ws + WS_V); const float* LFg = (const float*)(ws + WS_LOGF);
    const int tid = F.tid, c = tid >> 4, kg = tid & 15, lane = F.lane, wave = F.wave;
    for (int u = F.vcu; u < 2048 + NSEQ_S; u += F.G) {
        int t0, nvalid, h; unsigned char *qf, *vf, *lf; int qp, lp;
        if (u < 2048) { const int b = u >> 8, n = u & 63; h = (u >> 6) & 3; t0 = b * 2048 + n * 32; nvalid = 32;
            const size_t e0 = (size_t)t0 * DA + h * 128; qf = ws + WS_Q + e0 * 2; vf = ws + WS_V + e0 * 2; lf = ws + WS_LOGF + e0 * 4; qp = 1024; lp = 2048; }
        else { const int su = u - 2048, b = su >> 2; h = su & 3; t0 = TP + b * 8; nvalid = 8;
            unsigned char* base = sfr + (size_t)su * 65536; qf = base; vf = base + 8192; lf = base + 16384; qp = 256; lp = 512; }
        f32x4 lf0 = {0.f, 0.f, 0.f, 0.f}, lf1 = {0.f, 0.f, 0.f, 0.f}; v4u q8 = {0u, 0u, 0u, 0u}, v8 = {0u, 0u, 0u, 0u};
        if (c < nvalid) { const size_t e = (size_t)(t0 + c) * DA + h * 128 + 8 * kg;
            lf0 = NTL((const GAS f32x4*)(LFg + e)); lf1 = NTL((const GAS f32x4*)(LFg + e + 4)); q8 = NTL((const GAS v4u*)(Qg + e)); v8 = NTL((const GAS v4u*)(Vg + e)); }
        VM_WAIT();
        *(LAS f32x4*)(LB + c * 132 + 8 * kg) = lf0; *(LAS f32x4*)(LB + c * 132 + 8 * kg + 4) = lf1;
        { const unsigned vv[4] = {v8.x, v8.y, v8.z, v8.w};
#pragma unroll
          for (int j = 0; j < 4; ++j) { VT[(8 * kg + 2 * j) * 40 + c] = (bf16)(vv[j] & 0xffffu); VT[(8 * kg + 2 * j + 1) * 40 + c] = (bf16)(vv[j] >> 16); } }
        LDSBAR();
        if (tid < 128) { float run = 0.f;
#pragma unroll 8
            for (int cc = 0; cc < 32; ++cc) { run += LB[cc * 132 + tid]; LB[cc * 132 + tid] = run; } }
        LDSBAR();
        {
            const f32x4 b0 = *(LAS f32x4*)(LB + c * 132 + 8 * kg), b1 = *(LAS f32x4*)(LB + c * 132 + 8 * kg + 4);
            const f32x4 e0 = *(LAS f32x4*)(LB + 31 * 132 + 8 * kg), e1 = *(LAS f32x4*)(LB + 31 * 132 + 8 * kg + 4);
            const unsigned qq[4] = {q8.x, q8.y, q8.z, q8.w};
            float qd[8], kd[8], ke[8];
#pragma unroll
            for (int j = 0; j < 8; ++j) { const float lfj = j < 4 ? lf0[j] : lf1[j - 4], bj = j < 4 ? b0[j] : b1[j - 4], blj = j < 4 ? e0[j] : e1[j - 4];
                const float qj = (j & 1) ? bfhi(qq[j >> 1]) : bflo(qq[j >> 1]);
                const float kin = 1.0f - __expf(lfj);
                qd[j] = qj * __expf(bj); kd[j] = kin * __expf(-bj); ke[j] = kin * __expf(blj - bj); }
            v4u w; w.x = pk2(qd[0], qd[1]); w.y = pk2(qd[2], qd[3]); w.z = pk2(qd[4], qd[5]); w.w = pk2(qd[6], qd[7]);
            *(LAS v4u*)(QD + c * 136 + 8 * kg) = w;
            v4u wk; wk.x = pk2(kd[0], kd[1]); wk.y = pk2(kd[2], kd[3]); wk.z = pk2(kd[4], kd[5]); wk.w = pk2(kd[6], kd[7]);
            *(LAS v4u*)(KD + c * 136 + 8 * kg) = wk;
#pragma unroll
            for (int j = 0; j < 8; ++j) KET[(8 * kg + j) * 40 + c] = (bf16)f2bf(ke[j]);
#pragma unroll
            for (int g = 0; g < 2; ++g) { const int g4 = 2 * kg + g, m = g4 >> 3, r8 = g4 & 7, jh = r8 >> 2, q4 = r8 & 3, ch = c >> 4, lp_ = 16 * q4 + (c & 15);
                const int o = (((ch * 4 + m) * 64 + lp_) << 4) + jh * 8;
                v2u x; x.x = g ? w.z : w.x; x.y = g ? w.w : w.y;
                *(GAS v2u*)(qf + (size_t)(o >> 8) * qp + (o & 255)) = x; }
            if (c == 0) { const int o = 10240 + 32 * kg; unsigned char* p = lf + (size_t)(o >> 9) * lp + (o & 511);
                f32x4 d0, d1;
#pragma unroll
                for (int j = 0; j < 4; ++j) { d0[j] = __expf(e0[j]); d1[j] = __expf(e1[j]); }
                *(GAS f32x4*)p = d0; *(GAS f32x4*)(p + 16) = d1; }
        }
        LDSBAR();
        if (wave < 4) {
            const int cb = wave >> 1, sb = wave & 1, r = lane & 15, q = lane >> 4;
            f32x4 a4 = {0.f, 0.f, 0.f, 0.f};
            if (!(cb == 0 && sb == 1)) {
#pragma unroll
                for (int kk = 0; kk < 4; ++kk) { const bf16x8 a = *(LAS bf16x8*)(QD + (16 * cb + r) * 136 + 32 * kk + 8 * q), bb = *(LAS bf16x8*)(KD + (16 * sb + r) * 136 + 32 * kk + 8 * q);
                    a4 = __builtin_amdgcn_mfma_f32_16x16x32_bf16(a, bb, a4, 0, 0, 0); }
            }
#pragma unroll
            for (int i = 0; i < 4; ++i) { const int cc = 16 * cb + 4 * q + i, ss = 16 * sb + r; SC[cc * 40 + ss] = (bf16)f2bf(cc >= ss ? a4[i] : 0.f); }
        } else {
            const int tt = tid - 256;
#pragma unroll
            for (int rep = 0; rep < 2; ++rep) { const int p = tt + 256 * rep, kb = p >> 6, l2 = p & 63, o = p << 4;
                const v4u x = *(LAS v4u*)(KET + (16 * kb + (l2 & 15)) * 40 + 8 * (l2 >> 4));
                *(GAS v4u*)(lf + (size_t)(o >> 9) * lp + (o & 511)) = x;
                const v4u y = *(LAS v4u*)(VT + (16 * kb + (l2 & 15)) * 40 + 8 * (l2 >> 4));
                *(GAS v4u*)(vf + (size_t)(o >> 8) * qp + (o & 255)) = y; }
        }
        LDSBAR();
        if (tid < 128) { const int p = tid, ch = p >> 6, l2 = p & 63, o = 8192 + (p << 4);
            const v4u x = *(LAS v4u*)(SC + (16 * ch + (l2 & 15)) * 40 + 8 * (l2 >> 4));
            *(GAS v4u*)(lf + (size_t)(o >> 9) * lp + (o & 511)) = x; }
        LDSBAR();
    }
}

struct HgPre { v4u q, v, l0, l1; };
constexpr int HG_SLOT = 27648;
__device__ __forceinline__ void hg_chunk(const LAS unsigned char* sl, f32x4 (&S)[8], float* Orow, int nvalid, int vs, int lane) {
    const int r = lane & 15, q = lane >> 4;
    const bf16x8 vfr = *(const LAS bf16x8*)(sl + 16384 + ((vs * 64 + lane) << 4));
    f32x4 o0 = {0.f, 0.f, 0.f, 0.f}, o1 = {0.f, 0.f, 0.f, 0.f};
    { const bf16x8 s0 = *(const LAS bf16x8*)(sl + 24576 + (lane << 4)), s1 = *(const LAS bf16x8*)(sl + 24576 + ((64 + lane) << 4));
      o0 = __builtin_amdgcn_mfma_f32_16x16x32_bf16(s0, vfr, o0, 0, 0, 0); o1 = __builtin_amdgcn_mfma_f32_16x16x32_bf16(s1, vfr, o1, 0, 0, 0); }
#pragma unroll
    for (int m = 0; m < 4; ++m) {
        v4u sw; sw.x = pk2(S[2 * m][0], S[2 * m][1]); sw.y = pk2(S[2 * m][2], S[2 * m][3]); sw.z = pk2(S[2 * m + 1][0], S[2 * m + 1][1]); sw.w = pk2(S[2 * m + 1][2], S[2 * m + 1][3]);
        const bf16x8 sb = __builtin_bit_cast(bf16x8, sw);
        const bf16x8 a0 = *(const LAS bf16x8*)(sl + ((m * 64 + lane) << 4)), a1 = *(const LAS bf16x8*)(sl + (((4 + m) * 64 + lane) << 4));
        o0 = __builtin_amdgcn_mfma_f32_16x16x32_bf16(a0, sb, o0, 0, 0, 0); o1 = __builtin_amdgcn_mfma_f32_16x16x32_bf16(a1, sb, o1, 0, 0, 0);
    }
#pragma unroll
    for (int i = 0; i < 4; ++i) { const int c0 = 4 * q + i;
        if (c0 < nvalid) Orow[(size_t)c0 * DA + 16 * vs + r] = o0[i];
        if (c0 + 16 < nvalid) Orow[(size_t)(c0 + 16) * DA + 16 * vs + r] = o1[i]; }
#pragma unroll
    for (int kb = 0; kb < 8; ++kb) { const f32x4 d = *(const LAS f32x4*)(sl + 26624 + ((16 * kb + 4 * q) << 2));
        const bf16x8 ke = *(const LAS bf16x8*)(sl + 8192 + ((kb * 64 + lane) << 4));
        S[kb] = __builtin_amdgcn_mfma_f32_16x16x32_bf16(ke, vfr, S[kb] * d, 0, 0, 0); }
}
__device__ __forceinline__ void hg_seq(const Frame& F, unsigned char* ws, const float* s0, float* sout, float* Og, int seq, bool sample, int vs_base, int nvs) {
    LAS unsigned char* ring = F.lds;
    const int tid = F.tid, lane = F.lane, vs = vs_base + F.wave, r = lane & 15, q = lane >> 4;
    const bool active = F.wave < nvs, vload = (unsigned)((tid >> 6) - vs_base) < (unsigned)nvs;
    int nch, nvalid, t0, h; const unsigned char *qf, *vf, *lf; int qp, lp; size_t qstep, lstep;
    if (!sample) { const int b = seq >> 2; h = seq & 3; t0 = b * 2048; nch = 64; nvalid = 32; const size_t e0 = (size_t)t0 * DA + h * 128;
        qf = ws + WS_Q + e0 * 2; vf = ws + WS_V + e0 * 2; lf = ws + WS_LOGF + e0 * 4; qp = 1024; lp = 2048; qstep = 32 * 1024; lstep = 32 * 2048; }
    else { const int b = seq >> 2; h = seq & 3; t0 = TP + b * 8; nch = 1; nvalid = 8; const unsigned char* base = (const unsigned char*)sout + (size_t)seq * 65536;
        qf = base; vf = base + 8192; lf = base + 16384; qp = 256; lp = 512; qstep = 0; lstep = 0; }
    const size_t offq = (size_t)(tid >> 4) * qp + (tid & 15) * 16, offl0 = (size_t)(tid >> 5) * lp + (tid & 31) * 16, offl1 = (size_t)(16 + (tid >> 5)) * lp + (tid & 31) * 16, offl1c = tid < 160 ? offl1 : offl0;
    {
    f32x4 S[8];
    if (sample && active) {
#pragma unroll
        for (int kb = 0; kb < 8; ++kb)
#pragma unroll
            for (int i = 0; i < 4; ++i) S[kb][i] = s0[((size_t)seq * 128 + 16 * kb + 4 * q + i) * 128 + 16 * vs + r];
    } else {
#pragma unroll
        for (int kb = 0; kb < 8; ++kb) S[kb] = (f32x4){0.f, 0.f, 0.f, 0.f};
    }
    float* Ob = Og + (size_t)t0 * DA + h * 128;
#define HG_LOAD(R, n) do { if (sample) { if ((n) < nch) { R.q = NTL((const GAS v4u*)(qf + offq)); if (vload) R.v = NTL((const GAS v4u*)(vf + offq)); R.l0 = NTL((const GAS v4u*)(lf + offl0)); if (tid < 160) R.l1 = NTL((const GAS v4u*)(lf + offl1)); } } \
        else { const int n_ = (n) < nch ? (n) : nch - 1; const unsigned char* q_ = qf + (size_t)n_ * qstep; const unsigned char* v_ = vf + (size_t)n_ * qstep; const unsigned char* l_ = lf + (size_t)n_ * lstep; \
        R.q = NTL((const GAS v4u*)(q_ + offq)); R.v = NTL((const GAS v4u*)(v_ + offq)); R.l0 = NTL((const GAS v4u*)(l_ + offl0)); R.l1 = NTL((const GAS v4u*)(l_ + offl1c)); } } while (0)
#define HG_STORE(R, s) do { LAS unsigned char* d_ = ring + (s) * HG_SLOT; *(LAS v4u*)(d_ + 16 * tid) = R.q; if (vload) *(LAS v4u*)(d_ + 16384 + 16 * tid) = R.v; *(LAS v4u*)(d_ + 8192 + 16 * tid) = R.l0; \
        if (tid < 160) *(LAS v4u*)(d_ + 24576 + 16 * tid) = R.l1; } while (0)
    HgPre R0, R1, R2, R3, R4, R5;
    R0.l1 = R0.v = (v4u){0u, 0u, 0u, 0u}; R1.l1 = R1.v = (v4u){0u, 0u, 0u, 0u}; R2.l1 = R2.v = (v4u){0u, 0u, 0u, 0u}; R3.l1 = R3.v = (v4u){0u, 0u, 0u, 0u}; R4.l1 = R4.v = (v4u){0u, 0u, 0u, 0u}; R5.l1 = R5.v = (v4u){0u, 0u, 0u, 0u};
    HG_LOAD(R0, 0); HG_LOAD(R1, 1); HG_LOAD(R2, 2); HG_LOAD(R3, 3); HG_LOAD(R4, 4);
    HG_STORE(R0, 0); LDSBAR();
    for (int n = 0; n < nch; n += 6) {
        HG_LOAD(R5, n + 5); if (active) hg_chunk(ring, S, Ob + (size_t)(n + 0) * 32 * DA, nvalid, vs, lane); if (n + 1 < nch) HG_STORE(R1, 1); LDSBAR(); if (n + 1 >= nch) break;
        HG_LOAD(R0, n + 6); if (active) hg_chunk(ring + HG_SLOT, S, Ob + (size_t)(n + 1) * 32 * DA, nvalid, vs, lane); if (n + 2 < nch) HG_STORE(R2, 0); LDSBAR(); if (n + 2 >= nch) break;
        HG_LOAD(R1, n + 7); if (active) hg_chunk(ring, S, Ob + (size_t)(n + 2) * 32 * DA, nvalid, vs, lane); if (n + 3 < nch) HG_STORE(R3, 1); LDSBAR(); if (n + 3 >= nch) break;
        HG_LOAD(R2, n + 8); if (active) hg_chunk(ring + HG_SLOT, S, Ob + (size_t)(n + 3) * 32 * DA, nvalid, vs, lane); if (n + 4 < nch) HG_STORE(R4, 0); LDSBAR(); if (n + 4 >= nch) break;
        HG_LOAD(R3, n + 9); if (active) hg_chunk(ring, S, Ob + (size_t)(n + 4) * 32 * DA, nvalid, vs, lane); if (n + 5 < nch) HG_STORE(R5, 1); LDSBAR(); if (n + 5 >= nch) break;
        HG_LOAD(R4, n + 10); if (active) hg_chunk(ring + HG_SLOT, S, Ob + (size_t)(n + 5) * 32 * DA, nvalid, vs, lane); if (n + 6 < nch) HG_STORE(R0, 0); LDSBAR();
    }
    if (active) {
#pragma unroll
    for (int kb = 0; kb < 8; ++kb)
#pragma unroll
        for (int i = 0; i < 4; ++i) sout[((size_t)seq * 128 + 16 * kb + 4 * q + i) * 128 + 16 * vs + r] = S[kb][i];
    }
    LDSBAR();
    }
}


#undef HG_LOAD
#undef HG_STORE
struct SgPre { v4u a0, a1, b0, b1; };
template <class Epi>
__device__ __forceinline__ void small_gemm(const Frame& F, const bf16* A, const bf16* Bt, int row_base, int K, const Epi E) {
    constexpr int LDT = 136, BUF = 64 * LDT;
    LAS bf16* As = (LAS bf16*)F.lds; LAS bf16* Bs = As + 2 * BUF;
    const int tid = F.tid, lane = F.lane, w = F.wave, r = lane & 15, q = lane >> 4, prow = tid >> 3, pk = (tid & 7) * 8, ns = K / 128;
    for (int u = F.vcu; u < 256; u += F.G) {
        const int r0 = row_base + (u >> 4) * 64, c0 = (u & 15) * 64;
        const bf16* ap = A + (size_t)(r0 + prow) * K + pk; const bf16* bp = Bt + (size_t)(c0 + prow) * K + pk;
        f32x4 acc0 = {0.f, 0.f, 0.f, 0.f}, acc1 = {0.f, 0.f, 0.f, 0.f};
        const typename Epi::Pre ep0 = E.pre4(r0 + 16 * (w & 3) + r, c0 + 32 * (w >> 2) + 4 * q), ep1 = E.pre4(r0 + 16 * (w & 3) + r, c0 + 32 * (w >> 2) + 16 + 4 * q);
#define SG_LOAD(R, s_) do { if ((s_) < ns) { R.a0 = NTL((const GAS v4u*)(ap + (s_) * 128)); R.a1 = NTL((const GAS v4u*)(ap + (s_) * 128 + 64)); R.b0 = NTL((const GAS v4u*)(bp + (s_) * 128)); R.b1 = NTL((const GAS v4u*)(bp + (s_) * 128 + 64)); } } while (0)
#define SG_STORE(R, b_) do { *(LAS v4u*)(As + (b_) * BUF + prow * LDT + pk) = R.a0; *(LAS v4u*)(As + (b_) * BUF + prow * LDT + pk + 64) = R.a1; *(LAS v4u*)(Bs + (b_) * BUF + prow * LDT + pk) = R.b0; *(LAS v4u*)(Bs + (b_) * BUF + prow * LDT + pk + 64) = R.b1; } while (0)
#define SG_COMP(b_) do { _Pragma("unroll") for (int kk = 0; kk < 4; ++kk) { \
            const bf16x8 a_ = *(const LAS bf16x8*)(As + (b_) * BUF + (16 * (w & 3) + r) * LDT + 32 * kk + 8 * q); \
            const bf16x8 x0_ = *(const LAS bf16x8*)(Bs + (b_) * BUF + (32 * (w >> 2) + r) * LDT + 32 * kk + 8 * q), x1_ = *(const LAS bf16x8*)(Bs + (b_) * BUF + (32 * (w >> 2) + 16 + r) * LDT + 32 * kk + 8 * q); \
            acc0 = __builtin_amdgcn_mfma_f32_16x16x32_bf16(x0_, a_, acc0, 0, 0, 0); acc1 = __builtin_amdgcn_mfma_f32_16x16x32_bf16(x1_, a_, acc1, 0, 0, 0); } } while (0)
        SgPre R0, R1, R2, R3;
        SG_LOAD(R0, 0); SG_LOAD(R1, 1); SG_LOAD(R2, 2);
        SG_STORE(R0, 0); LDSBAR();
        for (int s = 0; s < ns; s += 4) {
            SG_LOAD(R3, s + 3); SG_COMP(0); if (s + 1 < ns) SG_STORE(R1, 1); LDSBAR(); if (s + 1 >= ns) break;
            SG_LOAD(R0, s + 4); SG_COMP(1); if (s + 2 < ns) SG_STORE(R2, 0); LDSBAR(); if (s + 2 >= ns) break;
            SG_LOAD(R1, s + 5); SG_COMP(0); if (s + 3 < ns) SG_STORE(R3, 1); LDSBAR(); if (s + 3 >= ns) break;
            SG_LOAD(R2, s + 6); SG_COMP(1); if (s + 4 < ns) SG_STORE(R0, 0); LDSBAR();
        }
#undef SG_LOAD
#undef SG_STORE
#undef SG_COMP
        { float ss = E.store4p(r0 + 16 * (w & 3) + r, c0 + 32 * (w >> 2) + 4 * q, acc0, ep0);
          ss += E.store4p(r0 + 16 * (w & 3) + r, c0 + 32 * (w >> 2) + 16 + 4 * q, acc1, ep1);
          if (E.has_norm()) {
              LAS float* RS_ = (LAS float*)F.lds;
              ss += __shfl_xor(ss, 16); ss += __shfl_xor(ss, 32);
              if (q == 0) RS_[(w >> 2) * 64 + 16 * (w & 3) + r] = ss;
              LDSBAR();
              if (tid < 64) E.row_store_s(r0 + tid, u & 15, RS_[tid] + RS_[64 + tid]);
              LDSBAR(); } }
    }
}


__device__ __forceinline__ void small_gemm_dual(const Frame& F, const bf16* ZA, const bf16* WA, const bf16* ZB, const bf16* WB, const bf16* SGA, const bf16* SGB, bf16* MG, int row_base) {
    constexpr int K = DA, LDT = 72, ARR = 64 * LDT, BUF = 4 * ARR, ns = K / 64;
    LAS bf16* L = (LAS bf16*)F.lds;
    const int tid = F.tid, lane = F.lane, w = F.wave, r = lane & 15, q = lane >> 4, prow = tid >> 3, pk = (tid & 7) * 8;
    for (int u = F.vcu; u < 256; u += F.G) {
        const int r0 = row_base + (u >> 4) * 64, c0 = (u & 15) * 64;
        const bf16* a1p = ZA + (size_t)(r0 + prow) * K + pk; const bf16* b1p = WA + (size_t)(c0 + prow) * K + pk;
        const bf16* a2p = ZB + (size_t)(r0 + prow) * K + pk; const bf16* b2p = WB + (size_t)(c0 + prow) * K + pk;
        const int orow = r0 + 16 * (w & 3) + r, ocol = c0 + 32 * (w >> 2) + 4 * q;
        const size_t o0 = (size_t)orow * DM + ocol, o1 = o0 + 16;
        const v2u ga0 = NTL((const GAS v2u*)(SGA + o0)), ga1 = NTL((const GAS v2u*)(SGA + o1)), gb0 = NTL((const GAS v2u*)(SGB + o0)), gb1 = NTL((const GAS v2u*)(SGB + o1));
        f32x4 aa0 = {0.f, 0.f, 0.f, 0.f}, aa1 = aa0, ab0 = aa0, ab1 = aa0;
#define SD_LOAD(R, s_) do { const int c_ = (s_) < ns ? (s_) : ns - 1; R.a0 = NTL((const GAS v4u*)(a1p + c_ * 64)); R.a1 = NTL((const GAS v4u*)(b1p + c_ * 64)); R.b0 = NTL((const GAS v4u*)(a2p + c_ * 64)); R.b1 = NTL((const GAS v4u*)(b2p + c_ * 64)); } while (0)
#define SD_STORE(R, b_) do { LAS bf16* d_ = L + (b_) * BUF + prow * LDT + pk; *(LAS v4u*)(d_) = R.a0; *(LAS v4u*)(d_ + ARR) = R.a1; *(LAS v4u*)(d_ + 2 * ARR) = R.b0; *(LAS v4u*)(d_ + 3 * ARR) = R.b1; } while (0)
#define SD_COMP(b_) do { const LAS bf16* s_ = L + (b_) * BUF; _Pragma("unroll") for (int kk = 0; kk < 2; ++kk) { const int ko_ = 32 * kk + 8 * q; \
            const bf16x8 a1_ = *(const LAS bf16x8*)(s_ + (16 * (w & 3) + r) * LDT + ko_), a2_ = *(const LAS bf16x8*)(s_ + 2 * ARR + (16 * (w & 3) + r) * LDT + ko_); \
            const bf16x8 x10_ = *(const LAS bf16x8*)(s_ + ARR + (32 * (w >> 2) + r) * LDT + ko_), x11_ = *(const LAS bf16x8*)(s_ + ARR + (32 * (w >> 2) + 16 + r) * LDT + ko_); \
            const bf16x8 x20_ = *(const LAS bf16x8*)(s_ + 3 * ARR + (32 * (w >> 2) + r) * LDT + ko_), x21_ = *(const LAS bf16x8*)(s_ + 3 * ARR + (32 * (w >> 2) + 16 + r) * LDT + ko_); \
            aa0 = __builtin_amdgcn_mfma_f32_16x16x32_bf16(x10_, a1_, aa0, 0, 0, 0); aa1 = __builtin_amdgcn_mfma_f32_16x16x32_bf16(x11_, a1_, aa1, 0, 0, 0); \
            ab0 = __builtin_amdgcn_mfma_f32_16x16x32_bf16(x20_, a2_, ab0, 0, 0, 0); ab1 = __builtin_amdgcn_mfma_f32_16x16x32_bf16(x21_, a2_, ab1, 0, 0, 0); } } while (0)
        SgPre R0, R1, R2, R3;
        SD_LOAD(R0, 0); SD_LOAD(R1, 1); SD_LOAD(R2, 2);
        SD_STORE(R0, 0); LDSBAR();
        for (int s = 0; s < ns; s += 4) {
            SD_LOAD(R3, s + 3); SD_COMP(0); if (s + 1 < ns) SD_STORE(R1, 1); LDSBAR(); if (s + 1 >= ns) break;
            SD_LOAD(R0, s + 4); SD_COMP(1); if (s + 2 < ns) SD_STORE(R2, 0); LDSBAR(); if (s + 2 >= ns) break;
            SD_LOAD(R1, s + 5); SD_COMP(0); if (s + 3 < ns) SD_STORE(R3, 1); LDSBAR(); if (s + 3 >= ns) break;
            SD_LOAD(R2, s + 6); SD_COMP(1); if (s + 4 < ns) SD_STORE(R0, 0); LDSBAR();
        }
#undef SD_LOAD
#undef SD_STORE
#undef SD_COMP
        { v2u w0; w0.x = pk2(bflo(ga0.x) * aa0[0] + bflo(gb0.x) * ab0[0], bfhi(ga0.x) * aa0[1] + bfhi(gb0.x) * ab0[1]); w0.y = pk2(bflo(ga0.y) * aa0[2] + bflo(gb0.y) * ab0[2], bfhi(ga0.y) * aa0[3] + bfhi(gb0.y) * ab0[3]);
          *(GAS v2u*)(MG + o0) = w0;
          v2u w1; w1.x = pk2(bflo(ga1.x) * aa1[0] + bflo(gb1.x) * ab1[0], bfhi(ga1.x) * aa1[1] + bfhi(gb1.x) * ab1[1]); w1.y = pk2(bflo(ga1.y) * aa1[2] + bflo(gb1.y) * ab1[2], bfhi(ga1.y) * aa1[3] + bfhi(gb1.y) * ab1[3]);
          *(GAS v2u*)(MG + o1) = w1; }
    }
}

__device__ __forceinline__ void zb_rows(unsigned char* ws, const float* cw, const float* st_c, float* out, int lane, int gw, int NGW) {
    bf16* BGb = (bf16*)(ws + WS_BG); const bf16* Ub = (const bf16*)(ws + WS_U);
    const int hl = lane & 31, hw = lane >> 5, c0 = 16 * hl;
    for (int t = 2 * gw + hw; t < T; t += 2 * NGW) {
        const bool smp = t >= TP; const int pos = smp ? ((t - TP) & 7) : (t & 2047), L = smp ? 8 : 2048, bb = smp ? ((t - TP) >> 3) : (t >> 11);
        const size_t e = (size_t)t * DA + c0;
        v4u bg[2], u0[2], x1[2], x2[2];
#pragma unroll
        for (int h = 0; h < 2; ++h) { bg[h] = NTL((const GAS v4u*)(BGb + e + 8 * h)); u0[h] = NTL((const GAS v4u*)(Ub + e + 8 * h));
            x1[h] = (pos >= 1) ? NTL((const GAS v4u*)(Ub + e - DA + 8 * h)) : (v4u){0u, 0u, 0u, 0u};
            x2[h] = (pos >= 2) ? NTL((const GAS v4u*)(Ub + e - 2 * DA + 8 * h)) : (v4u){0u, 0u, 0u, 0u}; }
#pragma unroll
        for (int h = 0; h < 2; ++h) {
            float um1[8], um2[8];
            { const v4u x = x1[h]; um1[0] = bflo(x.x); um1[1] = bfhi(x.x); um1[2] = bflo(x.y); um1[3] = bfhi(x.y); um1[4] = bflo(x.z); um1[5] = bfhi(x.z); um1[6] = bflo(x.w); um1[7] = bfhi(x.w); }
            { const v4u x = x2[h]; um2[0] = bflo(x.x); um2[1] = bfhi(x.x); um2[2] = bflo(x.y); um2[3] = bfhi(x.y); um2[4] = bflo(x.z); um2[5] = bfhi(x.z); um2[6] = bflo(x.w); um2[7] = bfhi(x.w); }
            if (smp && pos < 1) { const size_t so = ((size_t)bb * 2 + 1) * DA + c0 + 8 * h; const f32x4 a = *(const GAS f32x4*)(st_c + so), b = *(const GAS f32x4*)(st_c + so + 4);
                um1[0] = a.x; um1[1] = a.y; um1[2] = a.z; um1[3] = a.w; um1[4] = b.x; um1[5] = b.y; um1[6] = b.z; um1[7] = b.w; }
            if (smp && pos < 2) { const size_t so = ((size_t)bb * 2 + pos) * DA + c0 + 8 * h; const f32x4 a = *(const GAS f32x4*)(st_c + so), b = *(const GAS f32x4*)(st_c + so + 4);
                um2[0] = a.x; um2[1] = a.y; um2[2] = a.z; um2[3] = a.w; um2[4] = b.x; um2[5] = b.y; um2[6] = b.z; um2[7] = b.w; }
            const unsigned uw[4] = {u0[h].x, u0[h].y, u0[h].z, u0[h].w}, bw[4] = {bg[h].x, bg[h].y, bg[h].z, bg[h].w};
            const f32x4 w0a = *(const GAS f32x4*)(cw + c0 + 8 * h), w0b = *(const GAS f32x4*)(cw + c0 + 8 * h + 4), w1a = *(const GAS f32x4*)(cw + DA + c0 + 8 * h), w1b = *(const GAS f32x4*)(cw + DA + c0 + 8 * h + 4),
                        w2a = *(const GAS f32x4*)(cw + 2 * DA + c0 + 8 * h), w2b = *(const GAS f32x4*)(cw + 2 * DA + c0 + 8 * h + 4);
            float zb[8], uf[8];
#pragma unroll
            for (int j = 0; j < 8; ++j) { uf[j] = (j & 1) ? bfhi(uw[j >> 1]) : bflo(uw[j >> 1]); const float bgj = (j & 1) ? bfhi(bw[j >> 1]) : bflo(bw[j >> 1]);
                const float w0 = j < 4 ? w0a[j & 3] : w0b[j & 3], w1 = j < 4 ? w1a[j & 3] : w1b[j & 3], w2 = j < 4 ? w2a[j & 3] : w2b[j & 3];
                zb[j] = bgj * (w0 * um2[j] + w1 * um1[j] + w2 * uf[j]); }
            v4u zw; zw.x = pk2(zb[0], zb[1]); zw.y = pk2(zb[2], zb[3]); zw.z = pk2(zb[4], zb[5]); zw.w = pk2(zb[6], zb[7]);
            *(GAS v4u*)(BGb + e + 8 * h) = zw;
            if (pos >= L - 2) { float* so = out + (smp ? OUT_SCS : OUT_SCP) + ((size_t)bb * 2 + (pos - (L - 2))) * DA + c0 + 8 * h;
                *(GAS f32x4*)so = (f32x4){uf[0], uf[1], uf[2], uf[3]}; *(GAS f32x4*)(so + 4) = (f32x4){uf[4], uf[5], uf[6], uf[7]}; }
        }
    }
}


__device__ __forceinline__ int unit_pm_n5632(int L) { const int wgid = (L % 8) * 187 + L / 8, gid = wgid / 176, fm = gid * 8, gsz = (68 - fm) < 8 ? (68 - fm) : 8; return fm + ((wgid % 176) % gsz); }
__device__ __forceinline__ void rstd_prefetch(const Frame& F, const float* PP, const float* PS) {
    LAS int* PMT = (LAS int*)(F.lds + PMT_OFF); LAS float* RSL = (LAS float*)(F.lds + RSL_OFF);
    for (int i = 0; i < RSL_SLOTS; ++i) { const int L = i * F.G + (int)blockIdx.x; const bool ok = (L < 1496) && (F.G % 8 == 0);
        const int pm = ok ? unit_pm_n5632(L) : -1;
        if (ok && F.tid < 256) RSL[i * 256 + F.tid] = pg8::row_rstd(PP, PS, pm * 256 + F.tid);
        if (F.tid == 0) PMT[i] = pm; }
    __syncthreads();
}

__global__ void __launch_bounds__(NWAVES * 64, 2) mk_fwd(Args args) {
    extern __shared__ __attribute__((aligned(16))) unsigned char lds[];
    Frame F;
    F.lds = (LAS unsigned char*)lds;
    F.MISC = (volatile LAS unsigned*)(F.lds + MISC_OFF);
    F.tid = threadIdx.x; F.lane = F.tid & 63; F.wave = __builtin_amdgcn_readfirstlane(F.tid >> 6);
    F.G = gridDim.x; { const int bx = blockIdx.x; F.vcu = (F.G % 8 == 0) ? (bx % 8) * (F.G / 8) + bx / 8 : bx; }
    unsigned char* ws = args.ws;
    F.ctl = (gu32*)(ws + WS_CTL);
    for (int u = F.tid; u < (LDS_BYTES - LDSCTL_OFF) / 4; u += NWAVES * 64) ((LAS unsigned*)(F.lds + LDSCTL_OFF))[u] = 0u;
    __syncthreads();
    XcdBarrier bar = xcd_barrier_post((unsigned*)(F.ctl + CW_BAR), F.MISC + 8);
#define GRID_BAR() do { xcd_barrier(bar); REFRESH(); } while (0)
    float* out = args.out;
    bf16* XN = (bf16*)(ws + WS_XN); bf16* Hb = (bf16*)(ws + WS_H);
    const int NGW = F.G * NWAVES;
    const unsigned phmask = args.mask;
    const int first_idle = 1496 % F.G, n_idle = first_idle ? F.G - first_idle : F.G, my_idle = first_idle ? (int)blockIdx.x - first_idle : (int)blockIdx.x;
    const int INGW = n_idle * NWAVES;
#define IGW_ (my_idle * NWAVES + F.wave)
#if defined(PROBE_F) || defined(PROBE_G)
    int probe_two = 2; asm volatile("" : "+s"(probe_two));
#endif
#define GW_ (F.vcu * NWAVES + F.wave)
#define PARTP_ ((float*)(ws + WS_PARTP))
#define PARTS_ ((float*)(ws + WS_PARTS))
#define SCR_ ((LAS float*)(F.lds + F.wave * 16384))
#define REFRESH() do { int t_ = threadIdx.x; asm volatile("" : "+v"(t_)); F.tid = t_; F.lane = t_ & 63; F.wave = __builtin_amdgcn_readfirstlane(t_ >> 6); } while (0)

    if (phmask & (1u << 0)) {
#ifdef PROBE_C
    for (int rep_ = 0; rep_ < 3; ++rep_)
#endif
    {
        conv_w13(kin(6), kin(7), nullptr, ws, SCR_, F.lane, GW_, NGW);
        conv_w2(kin(8), ws, SCR_, F.lane, (GW_ + NGW / 4) % NGW, NGW);
        { const float* win = kin(10); bf16* WIN = (bf16*)(ws + WS_WIN);
          conv_mat(win, nullptr, NIN, DM, 2560, WIN, 0, 0, SCR_, F.lane, (GW_ + NGW / 2) % NGW, NGW);
          conv_mat(win + 2560, nullptr, NIN, DM, 512, WIN, 1, 2560, SCR_, F.lane, (GW_ + NGW / 8) % NGW, NGW);
          conv_mat(win + 3072, nullptr, NIN, DM, 512, WIN, 1, 2560 + 16, SCR_, F.lane, (GW_ + 3 * (NGW / 8)) % NGW, NGW);
          conv_mat(win + 3584, nullptr, NIN, DM, 2048, WIN, 0, 3584, SCR_, F.lane, (GW_ + 3 * (NGW / 4)) % NGW, NGW); }
        { const float* xp = kin(0); const float* xs = kin(1); const float* g1 = kin(5);
          for (int m = 2 * GW_; m < T; m += 2 * NGW) { const float* ra = m < TP ? xp + (size_t)m * DM : xs + (size_t)(m - TP) * DM;
              rms_row2_bf16(ra, ra + DM, g1, XN + (size_t)m * DM, XN + (size_t)(m + 1) * DM, F.lane); } }
    }
    GRID_BAR();
#ifdef PROBE_E
    for (int rep_ = 0; rep_ < 10; ++rep_) GRID_BAR();
#endif
#if defined(PROBE_E2) || defined(PROBE_E3) || defined(PROBE_E4) || defined(PROBE_E5)
    for (int rep_ = 0; rep_ < 10; ++rep_) xcd_barrier_probe(bar);
#endif
    }

    if (phmask & (1u << 1)) {
#ifdef PROBE_F
    _Pragma("clang loop unroll(disable)") for (int rep_ = 0; rep_ < probe_two; ++rep_)
#endif
    { pg8::Gemm g{XN, (const bf16*)(ws + WS_W13), T, 2 * DFF, DM}; pg8::StaticOrder S; S.init(T, 2 * DFF, F.G, (int)blockIdx.x);
      pg8::EpiSwiglu E{Hb, DFF, nullptr, nullptr, F.lds}; pg8::gemm_phase<pg8::EpiSwiglu, pg8::StaticOrder, true, true>(F.lds, g, S, E); }
    GRID_BAR();
    }

    if (phmask & (1u << 2)) {
#ifdef PROBE_G
    _Pragma("clang loop unroll(disable)") for (int rep_ = 0; rep_ < probe_two; ++rep_)
#endif
    { pg8::Gemm g{Hb, (const bf16*)(ws + WS_W2), TP, DM, DFF}; pg8::StaticOrder S; S.init(TP, DM, F.G, (int)blockIdx.x);
      pg8::EpiRes<true> E{kin(0), kin(1), out, XN, PARTP_, PARTS_, F.lds, kin(9)};
      if ((blockIdx.x >> 3) & 1) { small_gemm(F, Hb, (const bf16*)(ws + WS_W2), TP, DFF, pg8::EpiRes<true>{kin(0), kin(1), out, XN, PARTP_, PARTS_, F.lds, kin(9)}); REFRESH(); pg8::gemm_phase<pg8::EpiRes<true>, pg8::StaticOrder, true, true>(F.lds, g, S, E); }
      else { pg8::gemm_phase<pg8::EpiRes<true>, pg8::StaticOrder, true, true>(F.lds, g, S, E); REFRESH(); small_gemm(F, Hb, (const bf16*)(ws + WS_W2), TP, DFF, pg8::EpiRes<true>{kin(0), kin(1), out, XN, PARTP_, PARTS_, F.lds, kin(9)}); } }
    GRID_BAR();
    }

    if (phmask & (1u << 3)) {
    rstd_prefetch(F, PARTP_, PARTS_);
    { pg8::Gemm g{XN, (const bf16*)(ws + WS_WIN), T, NIN, DM}; pg8::StaticOrder S; S.init(T, NIN, F.G, (int)blockIdx.x);
      pg8::EpiMix E{(bf16*)(ws + WS_Q), (bf16*)(ws + WS_V), (bf16*)(ws + WS_OG), (bf16*)(ws + WS_BG), (bf16*)(ws + WS_U), (bf16*)(ws + WS_SGA), (bf16*)(ws + WS_SGB), (float*)(ws + WS_LOGF), kin(4), PARTP_, PARTS_, F.lds};
      pg8::gemm_phase<pg8::EpiMix, pg8::StaticOrder, true, true>(F.lds, g, S, E); }
    GRID_BAR();
    }

    if (phmask & (1u << 4)) {
    hg_prep(F, ws, (unsigned char*)(out + OUT_SHS));
    GRID_BAR();
    }

    if (phmask & (1u << 5)) {
    {
        float* Og = (float*)(ws + WS_XN); const float* st_h = kin(2); const float* st_c = kin(3);
        const int bid = (int)blockIdx.x, G = F.G;
        constexpr int NSCAN = 4 * NSEQ_P;
        if (G >= 2 * NSCAN) {
            for (int s = bid; s < NSEQ_S; s += G) hg_seq(F, ws, st_h, out + OUT_SHS, Og, s, true, 0, 8);
            if (bid < NSCAN) hg_seq(F, ws, nullptr, out + OUT_SHP, Og, bid >> 2, false, 2 * (bid & 3), 2);
            else {
                REFRESH();
                const int cgw = (bid - NSCAN) * NWAVES + F.wave, CNGW = (G - NSCAN) * NWAVES;
                zb_rows(ws, kin(11), st_c, out, F.lane, cgw, CNGW);
                conv_mat(kin(13), nullptr, DM, DA, DM, (bf16*)(ws + WS_WA), 0, 0, SCR_, F.lane, cgw, CNGW);
                conv_mat(kin(14), nullptr, DM, DA, DM, (bf16*)(ws + WS_WB), 0, 0, SCR_, F.lane, (cgw + CNGW / 4) % CNGW, CNGW);
                conv_mat(kin(15), nullptr, DM, DM, DM, (bf16*)(ws + WS_WO), 0, 0, SCR_, F.lane, (cgw + CNGW / 2) % CNGW, CNGW);
                conv_w13(kin(17), kin(18), nullptr, ws, SCR_, F.lane, cgw, CNGW);
                conv_w2(kin(19), ws, SCR_, F.lane, (cgw + CNGW / 3) % CNGW, CNGW);
            }
        } else {
            for (int s = bid; s < NSEQ_P; s += G) hg_seq(F, ws, nullptr, out + OUT_SHP, Og, s, false, 0, 8);
            for (int s = bid; s < NSEQ_S; s += G) hg_seq(F, ws, st_h, out + OUT_SHS, Og, s, true, 0, 8);
            REFRESH();
            zb_rows(ws, kin(11), st_c, out, F.lane, GW_, NGW);
            conv_mat(kin(13), nullptr, DM, DA, DM, (bf16*)(ws + WS_WA), 0, 0, SCR_, F.lane, GW_, NGW);
            conv_mat(kin(14), nullptr, DM, DA, DM, (bf16*)(ws + WS_WB), 0, 0, SCR_, F.lane, GW_, NGW);
            conv_mat(kin(15), nullptr, DM, DM, DM, (bf16*)(ws + WS_WO), 0, 0, SCR_, F.lane, GW_, NGW);
            conv_w13(kin(17), kin(18), nullptr, ws, SCR_, F.lane, GW_, NGW);
            conv_w2(kin(19), ws, SCR_, F.lane, GW_, NGW);
        }
    }
    GRID_BAR();
    }

    if (phmask & (1u << 6)) {
#ifdef PROBE_D
    for (int rep_ = 0; rep_ < 3; ++rep_)
#endif
    {
        const float* Og = (const float*)(ws + WS_XN); const bf16* OGb = (const bf16*)(ws + WS_OG); bf16* ZA = (bf16*)(ws + WS_ZA);
        const float* gh = kin(12);
        const int hl = F.lane & 31, hw = F.lane >> 5, c0 = 16 * hl;
        f32x4 gg[4];
#pragma unroll
        for (int j = 0; j < 4; ++j) gg[j] = *(const GAS f32x4*)(gh + c0 + 4 * j);
        for (int t = 2 * GW_ + hw; t < T; t += 2 * NGW) {
            const size_t e = (size_t)t * DA + c0;
            f32x4 o[4]; v4u og[2];
#pragma unroll
            for (int j = 0; j < 4; ++j) o[j] = NTL((const GAS f32x4*)(Og + e + 4 * j));
            og[0] = NTL((const GAS v4u*)(OGb + e)); og[1] = NTL((const GAS v4u*)(OGb + e + 8));
            float ss = 0.f;
#pragma unroll
            for (int j = 0; j < 4; ++j) ss += (o[j].x * o[j].x + o[j].y * o[j].y) + (o[j].z * o[j].z + o[j].w * o[j].w);
            ss += __shfl_xor(ss, 1); ss += __shfl_xor(ss, 2); ss += __shfl_xor(ss, 4);
            const float rstd = 1.f / sqrtf(ss * (1.f / 128.f) + EPS);
#pragma unroll
            for (int h = 0; h < 2; ++h) { const f32x4 a = o[2 * h] * rstd * gg[2 * h], b = o[2 * h + 1] * rstd * gg[2 * h + 1]; const v4u g8 = og[h];
                v4u za; za.x = pk2(a.x * bflo(g8.x), a.y * bfhi(g8.x)); za.y = pk2(a.z * bflo(g8.y), a.w * bfhi(g8.y)); za.z = pk2(b.x * bflo(g8.z), b.y * bfhi(g8.z)); za.w = pk2(b.z * bflo(g8.w), b.w * bfhi(g8.w));
                *(GAS v4u*)(ZA + e + 8 * h) = za; }
        }
    }
    GRID_BAR();
    }

    if (phmask & (1u << 7)) {
    { pg8::Gemm g{(const bf16*)(ws + WS_ZA), (const bf16*)(ws + WS_WA), TP, DM, DA}; pg8::StaticOrder S; S.init(TP, DM, F.G, (int)blockIdx.x);
      pg8::EpiGate<0> E{(const bf16*)(ws + WS_SGA), (bf16*)(ws + WS_MG)}; pg8::gemm_phase<pg8::EpiGate<0>, pg8::StaticOrder, true, true>(F.lds, g, S, E);
    }
    VM_WAIT();
    { pg8::Gemm g{(const bf16*)(ws + WS_BG), (const bf16*)(ws + WS_WB), TP, DM, DA}; pg8::StaticOrder S; S.init(TP, DM, F.G, (int)blockIdx.x);
      pg8::EpiGate<1> E{(const bf16*)(ws + WS_SGB), (bf16*)(ws + WS_MG)}; pg8::gemm_phase<pg8::EpiGate<1>, pg8::StaticOrder, true, true>(F.lds, g, S, E);
      small_gemm_dual(F, (const bf16*)(ws + WS_ZA), (const bf16*)(ws + WS_WA), (const bf16*)(ws + WS_BG), (const bf16*)(ws + WS_WB), (const bf16*)(ws + WS_SGA), (const bf16*)(ws + WS_SGB), (bf16*)(ws + WS_MG), TP); }
    GRID_BAR();
    }

    if (phmask & (1u << 8)) {
    { pg8::Gemm g{(const bf16*)(ws + WS_MG), (const bf16*)(ws + WS_WO), TP, DM, DM}; pg8::StaticOrder S; S.init(TP, DM, F.G, (int)blockIdx.x);
      pg8::EpiRes<false> E{out, out + (size_t)TP * DM, out, XN, PARTP_, PARTS_, F.lds, kin(16)};
      if ((blockIdx.x >> 3) & 1) { small_gemm(F, (const bf16*)(ws + WS_MG), (const bf16*)(ws + WS_WO), TP, DM, pg8::EpiRes<false>{out, out + (size_t)TP * DM, out, XN, PARTP_, PARTS_, F.lds, kin(16)}); REFRESH(); pg8::gemm_phase<pg8::EpiRes<false>, pg8::StaticOrder, true, true>(F.lds, g, S, E); }
      else { pg8::gemm_phase<pg8::EpiRes<false>, pg8::StaticOrder, true, true>(F.lds, g, S, E); REFRESH(); small_gemm(F, (const bf16*)(ws + WS_MG), (const bf16*)(ws + WS_WO), TP, DM, pg8::EpiRes<false>{out, out + (size_t)TP * DM, out, XN, PARTP_, PARTS_, F.lds, kin(16)}); } }
    GRID_BAR();
    }

    if (phmask & (1u << 9)) {
    rstd_prefetch(F, PARTP_, PARTS_);
    { pg8::Gemm g{XN, (const bf16*)(ws + WS_W13), T, 2 * DFF, DM}; pg8::StaticOrder S; S.init(T, 2 * DFF, F.G, (int)blockIdx.x);
      pg8::EpiSwiglu E{Hb, DFF, PARTP_, PARTS_, F.lds}; pg8::gemm_phase<pg8::EpiSwiglu, pg8::StaticOrder, true, true>(F.lds, g, S, E); }
    GRID_BAR();
    { pg8::Gemm g{Hb, (const bf16*)(ws + WS_W2), TP, DM, DFF}; pg8::StaticOrder S; S.init(TP, DM, F.G, (int)blockIdx.x);
      pg8::EpiRes<true> E{out, out + (size_t)TP * DM, out, nullptr, nullptr, nullptr, F.lds, nullptr};
      if ((blockIdx.x >> 3) & 1) { small_gemm(F, Hb, (const bf16*)(ws + WS_W2), TP, DFF, pg8::EpiRes<true>{out, out + (size_t)TP * DM, out, nullptr, nullptr, nullptr, F.lds, nullptr}); REFRESH(); pg8::gemm_phase<pg8::EpiRes<true>, pg8::StaticOrder, true, true>(F.lds, g, S, E); }
      else { pg8::gemm_phase<pg8::EpiRes<true>, pg8::StaticOrder, true, true>(F.lds, g, S, E); REFRESH(); small_gemm(F, Hb, (const bf16*)(ws + WS_W2), TP, DFF, pg8::EpiRes<true>{out, out + (size_t)TP * DM, out, nullptr, nullptr, nullptr, F.lds, nullptr}); } }
    GRID_BAR();
    }

    if (phmask & (1u << 10)) {
    { const float* gg_ = kin(20); for (int m = 2 * GW_; m < T; m += 2 * NGW) rms_row2_f32(out + (size_t)m * DM, gg_, F.lane, m + 1 < T); }
    }
#undef GW_
#undef PARTP_
#undef PARTS_
#undef SCR_
#undef IGW_
#undef REFRESH
}

extern "C" void kernel_launch(void* const* d_in, const int* in_sizes, int n_in, void* d_out, int out_size, void* d_ws, size_t ws_size, hipStream_t stream) {
    static int grid = 0;
    if (grid == 0) {
        if (n_in != 21 || in_sizes[0] != TP * DM || (size_t)out_size != OUT_END || ws_size < WS_END) { fprintf(stderr, "kernel_launch: unexpected shapes (n_in %d, in0 %d, out %d, ws %zu)\n", n_in, n_in > 0 ? in_sizes[0] : -1, out_size, ws_size); grid = -1; return; }
        int dev = 0, cus = 0, per_cu = 0;
        if (hipGetDevice(&dev) != hipSuccess || hipDeviceGetAttribute(&cus, hipDeviceAttributeMultiprocessorCount, dev) != hipSuccess) { grid = -1; return; }
        if (hipFuncSetAttribute((const void*)mk_fwd, hipFuncAttributeMaxDynamicSharedMemorySize, LDS_BYTES) != hipSuccess) { fprintf(stderr, "kernel_launch: hipFuncSetAttribute failed\n"); grid = -1; return; }
        if (hipOccupancyMaxActiveBlocksPerMultiprocessor(&per_cu, (const void*)mk_fwd, NWAVES * 64, LDS_BYTES) != hipSuccess || per_cu < 1) { fprintf(stderr, "kernel_launch: occupancy query says %d blocks per CU\n", per_cu); }
        (void)hipGetLastError();
        grid = cus;
    }
    if (grid < 0) return;
    if (hipMemsetAsync((char*)d_ws + WS_CTL, 0, CTL_ZERO_BYTES, stream) != hipSuccess) return;
    Args a{};
    for (int i = 0; i < 21; ++i) a.in[i] = (const float*)d_in[i];
    a.out = (float*)d_out; a.ws = (unsigned char*)d_ws; a.mask = 0x0000ffffu; a.pad = 0u;
    hipLaunchKernelGGL(mk_fwd, dim3(grid), dim3(NWAVES * 64), LDS_BYTES, stream, a);
#ifdef PROBE_PHASE
    (void)hipMemsetAsync((char*)d_ws + WS_CTL, 0, CTL_ZERO_BYTES, stream);
    a.mask = (PROBE_PHASE);
    hipLaunchKernelGGL(mk_fwd, dim3(grid), dim3(NWAVES * 64), LDS_BYTES, stream, a);
#endif
}
```

```cpp
#include <hip/hip_runtime.h>
#include <cstdio>
#include <cstdint>
namespace pg8 {
#define PG8_LAS __attribute__((address_space(3)))
typedef unsigned short bf16_t;
typedef short bf16x8 __attribute__((ext_vector_type(8)));
typedef float f32x4 __attribute__((ext_vector_type(4)));
typedef unsigned u32x4 __attribute__((ext_vector_type(4)));
constexpr int BM = 256, BK = 64, HALF = 128, HTB = HALF * BK * 2  , STAGE_BYTES = 8 * HTB, NXCD = 8, WGM = 8;

__host__ __device__ __forceinline__ int lds_byte(int r, int c) { const int st = (r >> 4) * 2 + (c >> 5), rr = r & 15, cc = c & 31, ob = rr * 64 + cc * 2; return st * 1024 + (ob ^ (((ob >> 9) & 1) << 5)); }
__host__ __device__ __forceinline__ void stage_rc(int b, int& R, int& C) { const int st = b / 1024, sb = b % 1024, swz = sb ^ (((sb >> 9) & 1) << 5); R = (st >> 1) * 16 + swz / 64; C = (st & 1) * 32 + (swz % 64) / 2; }
__host__ __device__ __forceinline__ int perm32(int rho) { const int n = rho >> 4, i = rho & 15; return 8 * (i >> 2) + 4 * n + (i & 3); }

struct Unit { int pm, pn; };
struct Gemm { const bf16_t* A; const bf16_t* Bt; int M, N, K; };

struct StaticOrder {
    int nM, nN, nwg, G, c;
    __host__ __device__ void init(int M, int N, int G_, int c_) { nM = M / BM; nN = N / BM; nwg = nM * nN; G = G_; c = c_; }
    __host__ __device__ bool next(int i, Unit& u) const {
        const long L = (long)i * G + c; if (L >= nwg) return false;
        int wgid = (int)L; { const int q = nwg / NXCD, r = nwg % NXCD, xcd = wgid % NXCD, off = wgid / NXCD; wgid = (xcd < r ? xcd * (q + 1) : r * (q + 1) + (xcd - r) * q) + off; }
        const int nig = WGM * nN, gid = wgid / nig, fm = gid * WGM, gsz = (nM - fm) < WGM ? (nM - fm) : WGM;
        u.pm = fm + ((wgid % nig) % gsz); u.pn = (wgid % nig) / gsz; return true;
    }
    __device__ __forceinline__ void a_ready(const Unit&) const {}
    __device__ __forceinline__ void done(const Unit&) const {}
};

__device__ __forceinline__ unsigned cvt_pk_bf16(float lo, float hi) { unsigned r; asm volatile("v_cvt_pk_bf16_f32 %0, %1, %2" : "=v"(r) : "v"(lo), "v"(hi)); return r; }

template <class Epi, class Sched, bool ALIGN_EPI = false, bool SP2 = false>
__device__ __forceinline__ void gemm_phase(PG8_LAS unsigned char* lds, const Gemm g, const Sched& S, const Epi& E) {
    const int tid = threadIdx.x, wid = __builtin_amdgcn_readfirstlane(tid >> 6), lane = tid & 63, wr = wid >> 2, wc = wid & 3, fr = lane & 15, fq = lane >> 4;
    const int K = g.K, nt = K / BK;
    unsigned voffA[2], voffB[2];
#pragma unroll
    for (int i = 0; i < 2; ++i) { int R, C; stage_rc(tid * 16 + i * 8192, R, C); const int Rb = Epi::PERM ? ((R & ~31) + perm32(R & 31)) : R;
        voffA[i] = (unsigned)(R * K + C) * 2u; voffB[i] = (unsigned)(Rb * K + C) * 2u; }
    const size_t kstep = (size_t)(BK * 2);
    const size_t hstep = (size_t)HALF * K * 2;
    const size_t tstep = 2 * hstep;
    const unsigned ldsw = (unsigned)wid * 1024u;
    const int aoff = lds_byte(wr * 64 + fr, fq * 8), boff = lds_byte(wc * 32 + fr, fq * 8);
#define PG8_SA(b, h) (((b) * 2 + (h)) * HTB)
#define PG8_SB(b, h) ((4 + (b) * 2 + (h)) * HTB)
#define PG8_STAGE(bufoff, gbase, voff) do { _Pragma("unroll") for (int _i = 0; _i < 2; ++_i) \
        __builtin_amdgcn_global_load_lds((const unsigned*)((const char*)(gbase) + (voff)[_i]), (PG8_LAS unsigned*)(lds + (bufoff) + ldsw + _i * 8192), 16, 0, 0); } while (0)
#define PG8_LDA(dst, b, h) do { _Pragma("unroll") for (int m = 0; m < 4; ++m) _Pragma("unroll") for (int k = 0; k < 2; ++k) dst[m][k] = *(const PG8_LAS bf16x8*)(lds + PG8_SA(b, h) + aoff + m * 2048 + k * 1024); } while (0)
#define PG8_LDB(dst, b, h) do { _Pragma("unroll") for (int n = 0; n < 2; ++n) _Pragma("unroll") for (int k = 0; k < 2; ++k) dst[n][k] = *(const PG8_LAS bf16x8*)(lds + PG8_SB(b, h) + boff + n * 2048 + k * 1024); } while (0)
#define PG8_MMA(ai, bj, At, Bt) do { __builtin_amdgcn_s_setprio(1); _Pragma("unroll") for (int m = 0; m < 4; ++m) _Pragma("unroll") for (int n = 0; n < 2; ++n) _Pragma("unroll") for (int k = 0; k < 2; ++k) \
        acc[ai][bj][m][n] = __builtin_amdgcn_mfma_f32_16x16x32_bf16(Bt[n][k], At[m][k], acc[ai][bj][m][n], 0, 0, 0); __builtin_amdgcn_s_setprio(0); } while (0)
#define PG8_WAIT_V(n) asm volatile("s_waitcnt vmcnt(" #n ")" ::: "memory")
#define PG8_WAIT_L(n) asm volatile("s_waitcnt lgkmcnt(" #n ")" ::: "memory")
#define PG8_BAR __builtin_amdgcn_s_barrier()
#define PG8_SCHED __builtin_amdgcn_sched_barrier(0)
    Unit cur, nxt; int ui = 0;
    if (!S.next(0, cur)) return;
    f32x4 acc[2][2][4][2];
#pragma unroll
    for (int a = 0; a < 2; ++a)
#pragma unroll
        for (int b = 0; b < 2; ++b)
#pragma unroll
            for (int m = 0; m < 4; ++m)
#pragma unroll
                for (int n = 0; n < 2; ++n) acc[a][b][m][n] = (f32x4){0.f, 0.f, 0.f, 0.f};
    bf16x8 At[4][2], B0[2][2], B1[2][2];
    const char* cA = (const char*)g.A + (size_t)cur.pm * tstep; const char* cB = (const char*)g.Bt + (size_t)cur.pn * tstep;
    S.a_ready(cur);
    if constexpr (SP2) {
        PG8_STAGE(PG8_SB(0, 0), cB, voffB); PG8_STAGE(PG8_SB(0, 1), cB + hstep, voffB); PG8_STAGE(PG8_SA(0, 0), cA, voffA); PG8_STAGE(PG8_SA(0, 1), cA + hstep, voffA);
        if (wr == 1) PG8_BAR;
        PG8_WAIT_V(2); PG8_BAR;
        PG8_STAGE(PG8_SB(1, 0), cB + kstep, voffB); PG8_STAGE(PG8_SA(1, 0), cA + kstep, voffA); PG8_STAGE(PG8_SB(1, 1), cB + hstep + kstep, voffB);
        PG8_WAIT_V(6); PG8_BAR;
    } else {
        PG8_STAGE(PG8_SB(0, 0), cB, voffB); PG8_STAGE(PG8_SA(0, 0), cA, voffA); PG8_STAGE(PG8_SB(0, 1), cB + hstep, voffB); PG8_STAGE(PG8_SA(0, 1), cA + hstep, voffA);
        if (wr == 1) PG8_BAR;
        PG8_WAIT_V(4); PG8_BAR;
        PG8_STAGE(PG8_SB(1, 0), cB + kstep, voffB); PG8_STAGE(PG8_SA(1, 0), cA + kstep, voffA); PG8_STAGE(PG8_SB(1, 1), cB + hstep + kstep, voffB);
        PG8_WAIT_V(6); PG8_BAR;
    }
    for (;;) {
        const bool has_next = S.next(ui + 1, nxt);
        const char* nA = has_next ? (const char*)g.A + (size_t)nxt.pm * tstep : cA; const char* nB = has_next ? (const char*)g.Bt + (size_t)nxt.pn * tstep : cB;
        for (int t = 0; t < nt; t += 2) {
            const bool last = (t == nt - 2);
            const char* a1 = cA + (size_t)(t + 1) * kstep;
            const char* a2 = last ? nA : cA + (size_t)(t + 2) * kstep; const char* b2 = last ? nB : cB + (size_t)(t + 2) * kstep;
            const char* a3 = a2 + kstep; const char* b3 = b2 + kstep;
            if (last && has_next) S.a_ready(nxt);
            if constexpr (SP2) {
            PG8_LDB(B0, 0, 0); PG8_LDB(B1, 0, 1); PG8_SCHED; PG8_LDA(At, 0, 0); PG8_STAGE(PG8_SA(1, 1), a1 + hstep, voffA);
            PG8_WAIT_V(8); PG8_WAIT_L(0); PG8_BAR; PG8_MMA(0, 0, At, B0); PG8_MMA(0, 1, At, B1); PG8_BAR; PG8_SCHED;
            PG8_LDA(At, 0, 1); PG8_STAGE(PG8_SB(0, 0), b2, voffB); PG8_STAGE(PG8_SB(0, 1), b2 + hstep, voffB); PG8_STAGE(PG8_SA(0, 0), a2, voffA);
            PG8_WAIT_V(8); PG8_WAIT_L(0); PG8_BAR; PG8_MMA(1, 0, At, B0); PG8_MMA(1, 1, At, B1); PG8_BAR; PG8_SCHED;
            PG8_LDB(B0, 1, 0); PG8_LDB(B1, 1, 1); PG8_SCHED; PG8_LDA(At, 1, 0); PG8_STAGE(PG8_SA(0, 1), a2 + hstep, voffA);
            PG8_WAIT_V(8); PG8_WAIT_L(0); PG8_BAR; PG8_MMA(0, 0, At, B0); PG8_MMA(0, 1, At, B1); PG8_BAR; PG8_SCHED;
            PG8_LDA(At, 1, 1); PG8_STAGE(PG8_SB(1, 0), b3, voffB); PG8_STAGE(PG8_SB(1, 1), b3 + hstep, voffB); PG8_STAGE(PG8_SA(1, 0), a3, voffA);
            PG8_WAIT_V(8); PG8_WAIT_L(0); PG8_BAR; PG8_MMA(1, 0, At, B0); PG8_MMA(1, 1, At, B1); PG8_BAR; PG8_SCHED;
            } else {
            PG8_LDB(B0, 0, 0); PG8_SCHED; PG8_LDA(At, 0, 0); PG8_STAGE(PG8_SA(1, 1), a1 + hstep, voffA);
            PG8_WAIT_L(8); PG8_BAR; PG8_WAIT_L(0); PG8_MMA(0, 0, At, B0); PG8_BAR; PG8_SCHED;
            PG8_LDB(B1, 0, 1); PG8_STAGE(PG8_SB(0, 0), b2, voffB);
            PG8_BAR; PG8_WAIT_L(0); PG8_MMA(0, 1, At, B1); PG8_BAR;
            PG8_LDA(At, 0, 1); PG8_STAGE(PG8_SA(0, 0), a2, voffA);
            PG8_BAR; PG8_WAIT_L(0); PG8_MMA(1, 0, At, B0); PG8_BAR; PG8_SCHED;
            PG8_STAGE(PG8_SB(0, 1), b2 + hstep, voffB);
            PG8_WAIT_V(6); PG8_BAR; PG8_MMA(1, 1, At, B1); PG8_BAR;
            PG8_LDB(B0, 1, 0); PG8_SCHED; PG8_LDA(At, 1, 0); PG8_STAGE(PG8_SA(0, 1), a2 + hstep, voffA);
            PG8_WAIT_L(8); PG8_BAR; PG8_WAIT_L(0); PG8_MMA(0, 0, At, B0); PG8_BAR; PG8_SCHED;
            PG8_LDB(B1, 1, 1); PG8_STAGE(PG8_SB(1, 0), b3, voffB);
            PG8_BAR; PG8_WAIT_L(0); PG8_MMA(0, 1, At, B1); PG8_BAR;
            PG8_LDA(At, 1, 1); PG8_STAGE(PG8_SA(1, 0), a3, voffA);
            PG8_BAR; PG8_WAIT_L(0); PG8_MMA(1, 0, At, B0); PG8_BAR; PG8_SCHED;
            PG8_STAGE(PG8_SB(1, 1), b3 + hstep, voffB);
            PG8_WAIT_V(6); PG8_BAR; PG8_MMA(1, 1, At, B1); PG8_BAR;
            }
        }
        if constexpr (ALIGN_EPI) { if (wr == 0) PG8_BAR; }
        if constexpr (!Epi::AFTER_DRAIN) { E(acc, cur, wr, wc, fr, fq); S.done(cur); }
        if (!has_next) break;
#pragma unroll
        for (int a = 0; a < 2; ++a)
#pragma unroll
            for (int b = 0; b < 2; ++b)
#pragma unroll
                for (int m = 0; m < 4; ++m)
#pragma unroll
                    for (int n = 0; n < 2; ++n) acc[a][b][m][n] = (f32x4){0.f, 0.f, 0.f, 0.f};
        cur = nxt; cA = nA; cB = nB; ++ui;
        if constexpr (ALIGN_EPI) { if (wr == 1) PG8_BAR; }
    }
    PG8_WAIT_V(0);
    if constexpr (!ALIGN_EPI) { if (wr == 0) PG8_BAR; }
    PG8_BAR;
    if constexpr (Epi::AFTER_DRAIN) { E.fused(acc, cur, wr, wc, fr, fq, lds, wid, lane); S.done(cur); }
#undef PG8_SA
#undef PG8_SB
#undef PG8_STAGE
#undef PG8_LDA
#undef PG8_LDB
#undef PG8_MMA
#undef PG8_WAIT_V
#undef PG8_WAIT_L
#undef PG8_BAR
#undef PG8_SCHED
}
}

constexpr int DM = 1024, DFF = 2816, DA = 512, NIN = 5632;
constexpr int TP = 16384, TS = 1024, T = TP + TS;
constexpr int NSEQ_P = 32, NSEQ_S = 512;
constexpr float EPS = 1e-6f;
constexpr int NWAVES = 8;

constexpr size_t OUT_Y = 0, OUT_SHP = (size_t)T * DM, OUT_SCP = OUT_SHP + 524288, OUT_SHS = OUT_SCP + 8192, OUT_SCS = OUT_SHS + 8388608, OUT_END = OUT_SCS + 131072;

constexpr size_t MiB = 1u << 20;
constexpr size_t WS_CTL = 0, CTL_ZERO_BYTES = 1 * MiB;
constexpr size_t WS_WIN = 1 * MiB, WS_WA = 12 * MiB, WS_WB = 13 * MiB, WS_WO = 14 * MiB;
constexpr size_t WS_W13 = 16 * MiB, WS_W2 = 27 * MiB;
constexpr size_t WS_XN = 32 * MiB + 512 * 1024;
constexpr size_t WS_ARENA = WS_XN + 34 * MiB;
constexpr size_t UNITB = (size_t)T * 512 * 2;
constexpr size_t WS_H = WS_ARENA;
constexpr size_t WS_SGA = WS_ARENA, WS_SGB = WS_ARENA + 2 * UNITB, WS_OG = WS_ARENA + 4 * UNITB, WS_BG = WS_ARENA + 5 * UNITB, WS_U = WS_ARENA + 6 * UNITB;
constexpr size_t WS_Q = WS_ARENA + 7 * UNITB, WS_V = WS_ARENA + 8 * UNITB, WS_LOGF = WS_ARENA + 9 * UNITB;
constexpr size_t WS_ZA = WS_Q, WS_ZB = WS_V, WS_MG = WS_LOGF;
constexpr size_t WS_PARTP = WS_ARENA + 11 * UNITB;
constexpr size_t WS_PARTS = WS_PARTP + (size_t)TP * 16;
constexpr size_t WS_END = WS_PARTS + (size_t)TS * 64;
static_assert(WS_END <= 256 * MiB, "ws map");
static_assert((size_t)T * DFF * 2 <= 6 * UNITB, "H fits");
constexpr int CW_BAR = 4096;

constexpr int RING_BYTES = 131072, LDSCTL_OFF = RING_BYTES, MISC_OFF = LDSCTL_OFF + 320, ROWSUM_OFF = RING_BYTES + 2048, PMT_OFF = RING_BYTES + 3072, RSL_OFF = RING_BYTES + 4096, RSL_SLOTS = 6, LDS_BYTES = 147456;

#define GAS __attribute__((address_space(1)))
#define LAS __attribute__((address_space(3)))
typedef unsigned short bf16;
typedef unsigned v4u __attribute__((ext_vector_type(4)));
typedef unsigned v2u __attribute__((ext_vector_type(2)));
typedef float f32x4 __attribute__((ext_vector_type(4)));
typedef short bf16x8 __attribute__((ext_vector_type(8)));
typedef GAS unsigned gu32;
#define NTL(p) (*(p))
#define LDS_WAIT() asm volatile("s_waitcnt lgkmcnt(0)" ::: "memory")
#define VM_WAIT() asm volatile("s_waitcnt vmcnt(0)" ::: "memory")
#define LDSBAR() do { asm volatile("s_waitcnt lgkmcnt(0)" ::: "memory"); __builtin_amdgcn_s_barrier(); asm volatile("" ::: "memory"); } while (0)
__device__ __forceinline__ unsigned f2bf(float f) { unsigned u = __builtin_bit_cast(unsigned, f); return (u + 0x7fffu + ((u >> 16) & 1u)) >> 16; }
typedef float f32x2_t_ __attribute__((ext_vector_type(2)));
typedef __bf16 bf16x2_t_ __attribute__((ext_vector_type(2)));
__device__ __forceinline__ unsigned pk2(float lo, float hi) { const f32x2_t_ v = {lo, hi}; return __builtin_bit_cast(unsigned, __builtin_convertvector(v, bf16x2_t_)); }
__device__ __forceinline__ float bf2f(unsigned short h) { return __builtin_bit_cast(float, (unsigned)h << 16); }
__device__ __forceinline__ float bflo(unsigned w) { return __builtin_bit_cast(float, w << 16); }
__device__ __forceinline__ float bfhi(unsigned w) { return __builtin_bit_cast(float, w & 0xffff0000u); }
__device__ __forceinline__ float sigmoidf_(float x) { return __builtin_amdgcn_rcpf(1.0f + __expf(-x)); }
__device__ __forceinline__ float siluf_(float x) { return x * sigmoidf_(x); }

#define XB_TMO      128
#define XB_XCNT(j)  (256  + 64 * (j))
#define XB_XSUB(j)  (1280 + 64 * (j))
#define XB_XGEN(j)  (2304 + 64 * (j))
#define XB_TOP      3328
#define XB_TOPGEN   3392
#define XCD_BAR_WORDS 3456
#define XB_SPIN_CAP (1u << 18)

__device__ __forceinline__ unsigned xb_ld(unsigned* p)              { return __hip_atomic_load(p, __ATOMIC_RELAXED, __HIP_MEMORY_SCOPE_AGENT); }
__device__ __forceinline__ unsigned xb_add(unsigned* p, unsigned v) { return __hip_atomic_fetch_add(p, v, __ATOMIC_RELAXED, __HIP_MEMORY_SCOPE_AGENT); }
__device__ __forceinline__ unsigned xb_xcc_id() { return (unsigned)__builtin_amdgcn_s_getreg((3 << 11) | 20) & 0xFu; }
#define XB_SPIN(cond, bar) do { unsigned _sp = 0; while (cond) { __builtin_amdgcn_s_sleep(1); \
    if ((++_sp & 255u) == 0u) { if (xb_ld(&(bar)[XB_TMO])) break; if (_sp > XB_SPIN_CAP) { atomicAdd(&(bar)[XB_TMO], 1u); break; } } } } while (0)

struct XcdBarrier {
    unsigned* bar; unsigned x;
    volatile LAS unsigned* st;
};

__device__ __forceinline__ XcdBarrier xcd_barrier_post(unsigned* bar, volatile LAS unsigned* st) {
    XcdBarrier b; b.bar = bar; b.x = xb_xcc_id(); b.st = st;
    if (threadIdx.x == 0) (void)xb_add(&bar[XB_XCNT(b.x)], 1u);
    return b;
}
__device__ __forceinline__ void xcd_barrier_complete(unsigned* bar, unsigned x, unsigned& nloc, unsigned& nx) {
    const unsigned G = gridDim.x * gridDim.y * gridDim.z;
    unsigned sum, cnt, mine, sp = 0u;
    for (;;) {
        sum = 0u; cnt = 0u; mine = 0u;
#pragma unroll
        for (unsigned j = 0; j < 16; ++j) { const unsigned c = xb_ld(&bar[XB_XCNT(j)]); sum += c; cnt += (c > 0u) ? 1u : 0u; mine = (j == x) ? c : mine; }
        if (sum == G) break;
        __builtin_amdgcn_s_sleep(1);
        if ((++sp & 255u) == 0u) { if (xb_ld(&bar[XB_TMO])) break; if (sp > XB_SPIN_CAP) { atomicAdd(&bar[XB_TMO], 1u); break; } }
    }
    nloc = mine > 0u ? mine : 1u; nx = cnt > 0u ? cnt : 1u;
}

__device__ __forceinline__ void xcd_barrier(const XcdBarrier& b) {
    asm volatile("s_waitcnt vmcnt(0)" ::: "memory");
    __syncthreads();
    if (threadIdx.x == 0) {
        unsigned* bar = b.bar;
        __builtin_amdgcn_s_waitcnt(0);
        unsigned nloc = b.st[0], nx = b.st[1];
        if (nloc == 0u) { xcd_barrier_complete(bar, b.x, nloc, nx); b.st[0] = nloc; b.st[1] = nx; }
        const unsigned old = xb_add(&bar[XB_XSUB(b.x)], 1u);
        const unsigned gen = old / nloc;
        if (old + 1u == (gen + 1u) * nloc) {
            __builtin_amdgcn_fence(__ATOMIC_RELEASE, "agent");
            asm volatile("s_waitcnt vmcnt(0)" ::: "memory");
            const unsigned og = xb_add(&bar[XB_TOP], 1u);
            const unsigned tg = og / nx;
            if (og + 1u == (tg + 1u) * nx) xb_add(&bar[XB_TOPGEN], 1u);
            else XB_SPIN(xb_ld(&bar[XB_TOPGEN]) == tg, bar);
            __builtin_amdgcn_fence(__ATOMIC_ACQUIRE, "agent");
            xb_add(&bar[XB_XGEN(b.x)], 1u);
            asm volatile("s_waitcnt vmcnt(0)" ::: "memory");
        } else {
            XB_SPIN(xb_ld(&bar[XB_XGEN(b.x)]) == gen, bar);
            __builtin_amdgcn_fence(__ATOMIC_ACQUIRE, "agent");
            asm volatile("s_waitcnt vmcnt(0)" ::: "memory");
        }
    }
    __syncthreads();
}


#if defined(PROBE_E2) || defined(PROBE_E3) || defined(PROBE_E4) || defined(PROBE_E5)
__device__ __forceinline__ void xcd_barrier_probe(const XcdBarrier& b) {
    asm volatile("s_waitcnt vmcnt(0)" ::: "memory");
    __syncthreads();
    if (threadIdx.x == 0) {
        unsigned* bar = b.bar;
        unsigned nloc = b.st[0], nx = b.st[1];
        const unsigned old = xb_add(&bar[XB_XSUB(b.x)], 1u);
        const unsigned gen = old / nloc;
        if (old + 1u == (gen + 1u) * nloc) {
#if !defined(PROBE_E3) && !defined(PROBE_E4)
            __builtin_amdgcn_fence(__ATOMIC_RELEASE, "agent");
#endif
            asm volatile("s_waitcnt vmcnt(0)" ::: "memory");
            const unsigned og = xb_add(&bar[XB_TOP], 1u);
            const unsigned tg = og / nx;
            if (og + 1u == (tg + 1u) * nx) xb_add(&bar[XB_TOPGEN], 1u);
            else XB_SPIN(xb_ld(&bar[XB_TOPGEN]) == tg, bar);
#if !defined(PROBE_E2) && !defined(PROBE_E4)
            __builtin_amdgcn_fence(__ATOMIC_ACQUIRE, "agent");
#endif
            xb_add(&bar[XB_XGEN(b.x)], 1u);
            asm volatile("s_waitcnt vmcnt(0)" ::: "memory");
        } else {
            XB_SPIN(xb_ld(&bar[XB_XGEN(b.x)]) == gen, bar);
#if !defined(PROBE_E2) && !defined(PROBE_E4) && !defined(PROBE_E5)
            __builtin_amdgcn_fence(__ATOMIC_ACQUIRE, "agent");
#endif
            asm volatile("s_waitcnt vmcnt(0)" ::: "memory");
        }
    }
    __syncthreads();
}
#endif

namespace pg8 {
static_assert(RSL_OFF + RSL_SLOTS * 1024 <= LDS_BYTES, "rstd slots inside the LDS allocation");
__device__ __forceinline__ float row_rstd(const float* PP, const float* PS, int row) {
    float ss;
    if (row < TP) { const f32x4 a = NTL((const f32x4*)(PP + (size_t)row * 4)); ss = (a[0] + a[1]) + (a[2] + a[3]); }
    else { const f32x4* p = (const f32x4*)(PS + (size_t)(row - TP) * 16); const f32x4 a = (NTL(p) + NTL(p + 1)) + (NTL(p + 2) + NTL(p + 3)); ss = (a[0] + a[1]) + (a[2] + a[3]); }
    return 1.0f / sqrtf(ss * (1.0f / DM) + EPS);
}
__device__ __forceinline__ int rstd_slot(PG8_LAS unsigned char* ldsb, int pm) {
    const PG8_LAS int* PMT = (const PG8_LAS int*)(ldsb + PMT_OFF); int slot = -1;
#pragma unroll
    for (int i = 0; i < RSL_SLOTS; ++i) if (PMT[i] == pm) slot = i;
    return slot;
}
struct EpiSwiglu {
    static constexpr bool PERM = false, AFTER_DRAIN = false;
    bf16_t* H; int ldh; const float* PP; const float* PS; PG8_LAS unsigned char* ldsb;
    __device__ __forceinline__ void operator()(const f32x4 (&acc)[2][2][4][2], const Unit& u, int wr, int wc, int fr, int fq) const {
        const int row0 = u.pm * BM + wr * 64 + fr, hid0 = u.pn * 128 + wc * 16 + 4 * fq;
        float rs[2][4];
#pragma unroll
        for (int ai = 0; ai < 2; ++ai)
#pragma unroll
            for (int m = 0; m < 4; ++m) rs[ai][m] = 1.0f;
        if (PP) { const int slot = rstd_slot(ldsb, u.pm); const PG8_LAS float* RSL = (const PG8_LAS float*)(ldsb + RSL_OFF) + (slot < 0 ? 0 : slot) * 256 + wr * 64 + fr;
#pragma unroll
            for (int ai = 0; ai < 2; ++ai)
#pragma unroll
                for (int m = 0; m < 4; ++m) rs[ai][m] = slot >= 0 ? RSL[ai * HALF + m * 16] : row_rstd(PP, PS, row0 + ai * HALF + m * 16); }
#pragma unroll
        for (int ai = 0; ai < 2; ++ai)
#pragma unroll
            for (int m = 0; m < 4; ++m) { bf16_t* rowp = H + (size_t)(row0 + ai * HALF + m * 16) * ldh + hid0;
#pragma unroll
                for (int bj = 0; bj < 2; ++bj) { const f32x4 a = acc[ai][bj][m][0] * rs[ai][m], b = acc[ai][bj][m][1] * rs[ai][m];
                    v2u w; w.x = pk2(siluf_(a[0]) * b[0], siluf_(a[1]) * b[1]); w.y = pk2(siluf_(a[2]) * b[2], siluf_(a[3]) * b[3]);
                    *(v2u*)(rowp + bj * 64) = w; } }
    }
};
template <bool HALF_ALPHA> struct EpiRes {
    static constexpr bool PERM = false, AFTER_DRAIN = false;
    static constexpr float alpha = HALF_ALPHA ? 0.5f : 1.0f;
    const float* srcP; const float* srcS; float* out; bf16_t* XNo; float* PP; float* PS; PG8_LAS unsigned char* ldsb; const float* gain;
    __device__ __forceinline__ bool has_norm() const { return XNo != nullptr; }
    __device__ __forceinline__ float store4(int row, int col, f32x4 a) const {
        const float* sb = (row < TP) ? srcP : srcS - (size_t)TP * DM; const size_t o = (size_t)row * DM + col;
        const f32x4 s = NTL((const f32x4*)(sb + o)); const f32x4 v = s + a * alpha; *(f32x4*)(out + o) = v;
        if (XNo) { const f32x4 gg = *(const f32x4*)(gain + col); v2u w; w.x = pk2(v[0] * gg[0], v[1] * gg[1]); w.y = pk2(v[2] * gg[2], v[3] * gg[3]); *(v2u*)(XNo + o) = w; return (v[0] * v[0] + v[1] * v[1]) + (v[2] * v[2] + v[3] * v[3]); }
        return 0.f;
    }
    __device__ __forceinline__ void row_store_s(int row, int slot, float ss) const { PS[(size_t)(row - TP) * 16 + slot] = ss; }
    struct Pre { f32x4 s; };
    __device__ __forceinline__ Pre pre4(int row, int col) const { const float* sb = (row < TP) ? srcP : srcS - (size_t)TP * DM; Pre p; p.s = NTL((const f32x4*)(sb + (size_t)row * DM + col)); return p; }
    __device__ __forceinline__ float store4pg(int row, int col, f32x4 a, const Pre& p, f32x4 gg) const {
        const size_t o = (size_t)row * DM + col; const f32x4 v = p.s + a * alpha; *(f32x4*)(out + o) = v;
        if (XNo) { v2u w; w.x = pk2(v[0] * gg[0], v[1] * gg[1]); w.y = pk2(v[2] * gg[2], v[3] * gg[3]); *(v2u*)(XNo + o) = w; return (v[0] * v[0] + v[1] * v[1]) + (v[2] * v[2] + v[3] * v[3]); }
        return 0.f;
    }
    __device__ __forceinline__ float store4p(int row, int col, f32x4 a, const Pre& p) const {
        const size_t o = (size_t)row * DM + col; const f32x4 v = p.s + a * alpha; *(f32x4*)(out + o) = v;
        if (XNo) { const f32x4 gg = *(const f32x4*)(gain + col); v2u w; w.x = pk2(v[0] * gg[0], v[1] * gg[1]); w.y = pk2(v[2] * gg[2], v[3] * gg[3]); *(v2u*)(XNo + o) = w; return (v[0] * v[0] + v[1] * v[1]) + (v[2] * v[2] + v[3] * v[3]); }
        return 0.f;
    }
    __device__ __forceinline__ void operator()(const f32x4 (&acc)[2][2][4][2], const Unit& u, int wr, int wc, int fr, int fq) const {
        const int row0 = u.pm * BM + wr * 64 + fr, col0 = u.pn * BM + wc * 32 + 4 * fq;
        PG8_LAS float* ROWSUM = (PG8_LAS float*)(ldsb + ROWSUM_OFF);
        const bool norm = has_norm();
        if (norm) { if (threadIdx.x < 256) ROWSUM[threadIdx.x] = 0.f; asm volatile("s_waitcnt lgkmcnt(0)" ::: "memory"); __builtin_amdgcn_s_barrier(); asm volatile("" ::: "memory"); }
        f32x4 gg[2][2];
#pragma unroll
        for (int bj = 0; bj < 2; ++bj)
#pragma unroll
            for (int n = 0; n < 2; ++n) gg[bj][n] = norm ? *(const f32x4*)(gain + col0 + bj * HALF + n * 16) : (f32x4){0.f, 0.f, 0.f, 0.f};
#pragma unroll
        for (int am = 0; am < 4; ++am) {
            const int ai = am >> 1, mb = (am & 1) * 2;
            Pre pv[2][2][2];
#pragma unroll
            for (int mm = 0; mm < 2; ++mm)
#pragma unroll
                for (int bj = 0; bj < 2; ++bj)
#pragma unroll
                    for (int n = 0; n < 2; ++n) pv[mm][bj][n] = pre4(row0 + ai * HALF + (mb + mm) * 16, col0 + bj * HALF + n * 16);
#pragma unroll
            for (int mm = 0; mm < 2; ++mm) { const int m = mb + mm; float ss = 0.f;
#pragma unroll
                for (int bj = 0; bj < 2; ++bj)
#pragma unroll
                    for (int n = 0; n < 2; ++n) ss += store4pg(row0 + ai * HALF + m * 16, col0 + bj * HALF + n * 16, acc[ai][bj][m][n], pv[mm][bj][n], gg[bj][n]);
                if (norm) { ss += __shfl_xor(ss, 16); ss += __shfl_xor(ss, 32); if (fq == 0) (void)__hip_atomic_fetch_add(ROWSUM + ai * HALF + wr * 64 + m * 16 + fr, ss, __ATOMIC_RELAXED, __HIP_MEMORY_SCOPE_WORKGROUP); } }
        }
        if (norm) { asm volatile("s_waitcnt lgkmcnt(0)" ::: "memory"); __builtin_amdgcn_s_barrier(); asm volatile("" ::: "memory");
            if (threadIdx.x < 256) PP[(size_t)(u.pm * BM + threadIdx.x) * 4 + u.pn] = ROWSUM[threadIdx.x]; }
    }
};
template <int MODE> struct EpiGate {
    static constexpr bool PERM = false, AFTER_DRAIN = false;
    const bf16_t* SG; bf16_t* MG;
    __device__ __forceinline__ bool has_norm() const { return false; }
    __device__ __forceinline__ void row_store_s(int, int, float) const {}
    struct Pre { v2u g, m; };
    __device__ __forceinline__ Pre pre4(int row, int col) const { const size_t o = (size_t)row * DM + col; Pre p; p.g = NTL((const v2u*)(SG + o)); p.m = (v2u){0u, 0u}; if (MODE == 1) p.m = NTL((const v2u*)(MG + o)); return p; }
    __device__ __forceinline__ float store4p(int row, int col, f32x4 a, const Pre& p) const {
        const size_t o = (size_t)row * DM + col;
        float r0 = bflo(p.g.x) * a[0], r1 = bfhi(p.g.x) * a[1], r2 = bflo(p.g.y) * a[2], r3 = bfhi(p.g.y) * a[3];
        if (MODE == 1) { r0 += bflo(p.m.x); r1 += bfhi(p.m.x); r2 += bflo(p.m.y); r3 += bfhi(p.m.y); }
        v2u w; w.x = pk2(r0, r1); w.y = pk2(r2, r3); *(v2u*)(MG + o) = w; return 0.f;
    }
    __device__ __forceinline__ float store4(int row, int col, f32x4 a) const {
        const size_t o = (size_t)row * DM + col; const v2u g = NTL((const v2u*)(SG + o));
        float r0 = bflo(g.x) * a[0], r1 = bfhi(g.x) * a[1], r2 = bflo(g.y) * a[2], r3 = bfhi(g.y) * a[3];
        if (MODE == 1) { const v2u p = NTL((const v2u*)(MG + o)); r0 += bflo(p.x); r1 += bfhi(p.x); r2 += bflo(p.y); r3 += bfhi(p.y); }
        v2u w; w.x = pk2(r0, r1); w.y = pk2(r2, r3); *(v2u*)(MG + o) = w; return 0.f;
    }
    __device__ __forceinline__ void operator()(const f32x4 (&acc)[2][2][4][2], const Unit& u, int wr, int wc, int fr, int fq) const {
        const int row0 = u.pm * BM + wr * 64 + fr, col0 = u.pn * BM + wc * 32 + 4 * fq;
#pragma unroll
        for (int am = 0; am < 4; ++am) {
            const int ai = am >> 1, mb = (am & 1) * 2;
            Pre pv[2][2][2];
#pragma unroll
            for (int mm = 0; mm < 2; ++mm)
#pragma unroll
                for (int bj = 0; bj < 2; ++bj)
#pragma unroll
                    for (int n = 0; n < 2; ++n) pv[mm][bj][n] = pre4(row0 + ai * HALF + (mb + mm) * 16, col0 + bj * HALF + n * 16);
#pragma unroll
            for (int mm = 0; mm < 2; ++mm)
#pragma unroll
                for (int bj = 0; bj < 2; ++bj)
#pragma unroll
                    for (int n = 0; n < 2; ++n) (void)store4p(row0 + ai * HALF + (mb + mm) * 16, col0 + bj * HALF + n * 16, acc[ai][bj][mb + mm][n], pv[mm][bj][n]);
        }
    }
};
struct EpiMix {
    static constexpr bool PERM = false, AFTER_DRAIN = false;
    bf16_t *Q, *V, *OG, *BG, *U, *SGA, *SGB; float* LOGF; const float* lbl; const float* PP; const float* PS; PG8_LAS unsigned char* ldsb;
    __device__ __forceinline__ void operator()(const f32x4 (&acc_)[2][2][4][2], const Unit& u, int wr, int wc, int fr, int fq) const {
        const int pn = u.pn, row0 = u.pm * BM + wr * 64 + fr;
        f32x4 acc[2][2][4][2];
        { float rs[2][4]; const int slot_ = rstd_slot(ldsb, u.pm); const PG8_LAS float* RSL_ = (const PG8_LAS float*)(ldsb + RSL_OFF) + (slot_ < 0 ? 0 : slot_) * 256 + wr * 64 + fr;
#pragma unroll
          for (int ai = 0; ai < 2; ++ai)
#pragma unroll
              for (int m = 0; m < 4; ++m) { rs[ai][m] = slot_ >= 0 ? RSL_[ai * HALF + m * 16] : row_rstd(PP, PS, row0 + ai * HALF + m * 16); }
#pragma unroll
          for (int ai = 0; ai < 2; ++ai)
#pragma unroll
              for (int m = 0; m < 4; ++m)
#pragma unroll
                  for (int bj = 0; bj < 2; ++bj)
#pragma unroll
                      for (int n = 0; n < 2; ++n) acc[ai][bj][m][n] = acc_[ai][bj][m][n] * rs[ai][m]; }
        if (pn >= 10 && pn < 14) {
            const int ch0 = (pn - 10) * 128 + wc * 16 + 4 * fq;
#pragma unroll
            for (int ai = 0; ai < 2; ++ai)
#pragma unroll
                for (int m = 0; m < 4; ++m) { bf16_t* rowp = U + (size_t)(row0 + ai * HALF + m * 16) * DA + ch0;
#pragma unroll
                    for (int bj = 0; bj < 2; ++bj) { const f32x4 a = acc[ai][bj][m][0], b = acc[ai][bj][m][1];
                        v2u w; w.x = pk2(a[0] * b[0], a[1] * b[1]); w.y = pk2(a[2] * b[2], a[3] * b[3]); *(v2u*)(rowp + bj * 64) = w; } }
            return;
        }
        const int colt = wc * 32 + 4 * fq;
        if (pn == 2 || pn == 3) {
            const int c0 = (pn - 2) * 256 + colt;
#pragma unroll
            for (int bj = 0; bj < 2; ++bj)
#pragma unroll
                for (int n = 0; n < 2; ++n) { const int c = c0 + bj * HALF + n * 16;
                    const f32x4 l0 = *(const f32x4*)(lbl + c), l1 = *(const f32x4*)(lbl + 512 + c); f32x4 lb;
#pragma unroll
                    for (int i = 0; i < 4; ++i) lb[i] = sigmoidf_(l0[i] - l1[i]);
#pragma unroll
                    for (int ai = 0; ai < 2; ++ai)
#pragma unroll
                        for (int m = 0; m < 4; ++m) { const f32x4 z = acc[ai][bj][m][n]; f32x4 o;
#pragma unroll
                            for (int i = 0; i < 4; ++i) o[i] = __logf(lb[i] + (1.0f - lb[i]) * sigmoidf_(z[i]));
                            *(f32x4*)(LOGF + (size_t)(row0 + ai * HALF + m * 16) * DA + c) = o; } }
            return;
        }
        bf16_t* base; int ld, c0, act;
        if (pn < 2) { base = Q; ld = DA; c0 = pn * 256; act = 0; }
        else if (pn < 6) { base = V; ld = DA; c0 = (pn - 4) * 256; act = 0; }
        else if (pn < 8) { base = OG; ld = DA; c0 = (pn - 6) * 256; act = 1; }
        else if (pn < 10) { base = BG; ld = DA; c0 = (pn - 8) * 256; act = 0; }
        else if (pn < 18) { base = SGA; ld = DM; c0 = (pn - 14) * 256; act = 2; }
        else { base = SGB; ld = DM; c0 = (pn - 18) * 256; act = 2; }
        c0 += colt;
#pragma unroll
        for (int ai = 0; ai < 2; ++ai)
#pragma unroll
            for (int m = 0; m < 4; ++m) { bf16_t* rowp = base + (size_t)(row0 + ai * HALF + m * 16) * ld + c0;
#pragma unroll
                for (int bj = 0; bj < 2; ++bj)
#pragma unroll
                    for (int n = 0; n < 2; ++n) { f32x4 a = acc[ai][bj][m][n];
                        if (act == 1) { a[0] = siluf_(a[0]); a[1] = siluf_(a[1]); a[2] = siluf_(a[2]); a[3] = siluf_(a[3]); }
                        else if (act == 2) { a[0] = sigmoidf_(a[0]); a[1] = sigmoidf_(a[1]); a[2] = sigmoidf_(a[2]); a[3] = sigmoidf_(a[3]); }
                        v2u w; w.x = pk2(a[0], a[1]); w.y = pk2(a[2], a[3]); *(v2u*)(rowp + bj * HALF + n * 16) = w; } }
    }
};
}

struct Frame {
    LAS unsigned char* lds;
    volatile LAS unsigned* MISC;
    gu32* ctl;
    int tid, lane, wave, vcu, G;
};
struct Args { const float* in[21]; float* out; unsigned char* ws; unsigned mask; unsigned pad; };
typedef const __attribute__((address_space(4))) Args* KArgs;
__device__ __forceinline__ const float* kin(int k) { KArgs p = (KArgs)__builtin_amdgcn_kernarg_segment_ptr(); asm volatile("" : "+s"(p)); return p->in[k]; }

__device__ __forceinline__ float wave_sum(float v) {
#pragma unroll
    for (int o = 1; o < 64; o <<= 1) v += __shfl_xor(v, o);
    return v;
}
__device__ __forceinline__ void transpose_item(const float* W, const float* g, int ldw, int K, int ncols, bf16* WT, int mode, int roff, LAS float* scr, int item, int lane) {
    const int nblk = ncols / 32, kb = item / nblk, nb = item % nblk, k0 = 64 * kb, n0 = 32 * nb;
    const float g0 = g ? g[k0 + lane] : 1.0f;
#pragma unroll 8
    for (int i = 0; i < 32; ++i) { const int kk = 2 * i + (lane >> 5); scr[kk * 33 + (lane & 31)] = W[(size_t)(k0 + kk) * ldw + n0 + (lane & 31)] * __shfl(g0, kk); }
    LDS_WAIT(); asm volatile("" ::: "memory");
    const int c = lane & 7;
#pragma unroll
    for (int j = 0; j < 4; ++j) { const int n = (lane >> 3) + 8 * j; const LAS float* s = scr + (8 * c) * 33 + n;
        v4u o; o.x = pk2(s[0 * 33], s[1 * 33]); o.y = pk2(s[2 * 33], s[3 * 33]); o.z = pk2(s[4 * 33], s[5 * 33]); o.w = pk2(s[6 * 33], s[7 * 33]);
        const int jc = n0 + n; const int drow = mode ? roff + ((jc >> 4) << 5) + (jc & 15) : roff + jc;
        *(GAS v4u*)(WT + (size_t)drow * K + k0 + 8 * c) = o; }
    LDS_WAIT(); asm volatile("" ::: "memory");
}
__device__ __forceinline__ void conv_mat(const float* W, const float* g, int ldw, int K, int ncols, bf16* WT, int mode, int roff, LAS float* scr, int lane, int gw, int NGW) {
    const int nitems = (K / 64) * (ncols / 32);
    for (int it = gw; it < nitems; it += NGW) transpose_item(W, g, ldw, K, ncols, WT, mode, roff, scr, it, lane);
}
__device__ __forceinline__ void conv_w13(const float* w1, const float* w3, const float* g, unsigned char* ws, LAS float* scr, int lane, int gw, int NGW) {
    bf16* W13 = (bf16*)(ws + WS_W13);
    conv_mat(w1, g, DFF, DM, DFF, W13, 1, 0, scr, lane, gw, NGW);
    conv_mat(w3, g, DFF, DM, DFF, W13, 1, 16, scr, lane, (gw + NGW / 2) % NGW, NGW);
}
__device__ __forceinline__ void conv_w2(const float* w2, unsigned char* ws, LAS float* scr, int lane, int gw, int NGW) {
    conv_mat(w2, nullptr, DM, DFF, DM, (bf16*)(ws + WS_W2), 0, 0, scr, lane, gw, NGW);
}
__device__ __forceinline__ void rms_row2_bf16(const float* xrowA, const float* xrowB, const float* g, bf16* orowA, bf16* orowB, int lane) {
    const int hl = lane & 31, hw = lane >> 5;
    const GAS f32x4* xr = (const GAS f32x4*)(hw ? xrowB : xrowA) + hl; const GAS f32x4* gr = (const GAS f32x4*)g + hl;
    f32x4 v[8]; float s = 0.f;
#pragma unroll
    for (int j = 0; j < 8; ++j) { v[j] = xr[32 * j]; s += (v[j].x * v[j].x + v[j].y * v[j].y) + (v[j].z * v[j].z + v[j].w * v[j].w); }
#pragma unroll
    for (int o = 1; o < 32; o <<= 1) s += __shfl_xor(s, o);
    const float rstd = 1.f / sqrtf(s * (1.f / DM) + EPS);
    GAS v2u* o8 = (GAS v2u*)(hw ? orowB : orowA) + hl;
#pragma unroll
    for (int j = 0; j < 8; ++j) { const f32x4 gg = gr[32 * j]; v2u w; w.x = pk2(v[j].x * rstd * gg.x, v[j].y * rstd * gg.y); w.y = pk2(v[j].z * rstd * gg.z, v[j].w * rstd * gg.w); o8[32 * j] = w; }
}
__device__ __forceinline__ void rms_row2_f32(float* xrow0, const float* g, int lane, bool second_valid) {
    const int hl = lane & 31, hw = lane >> 5;
    if (hw && !second_valid) return;
    GAS f32x4* xr = (GAS f32x4*)(xrow0 + (size_t)hw * DM) + hl; const GAS f32x4* gr = (const GAS f32x4*)g + hl;
    f32x4 v[8]; float s = 0.f;
#pragma unroll
    for (int j = 0; j < 8; ++j) { v[j] = NTL(xr + 32 * j); s += (v[j].x * v[j].x + v[j].y * v[j].y) + (v[j].z * v[j].z + v[j].w * v[j].w); }
#pragma unroll
    for (int o = 1; o < 32; o <<= 1) s += __shfl_xor(s, o);
    const float rstd = 1.f / sqrtf(s * (1.f / DM) + EPS);
#pragma unroll
    for (int j = 0; j < 8; ++j) { const f32x4 gg = gr[32 * j]; xr[32 * j] = v[j] * rstd * gg; }
}

__device__ __forceinline__ void hg_prep(const Frame& F, unsigned char* ws, unsigned char* sfr) {
    LAS unsigned char* L = F.lds;
    LAS float* LB = (LAS float*)L;
    LAS bf16* QD = (LAS bf16*)(L + 16896);
    LAS bf16* KD = (LAS bf16*)(L + 16896 + 8704);
    LAS bf16* KET = (LAS bf16*)(L + 16896 + 2 * 8704);
    LAS bf16* VT = (LAS bf16*)(L + 16896 + 2 * 8704 + 10240);
    LAS bf16* SC = (LAS bf16*)(L + 16896 + 2 * 8704 + 2 * 10240);
    const bf16* Qg = (const bf16*)(ws + WS_Q); const bf16* Vg = (const bf16*)(ws + WS_V); const float* LFg = (const float*)(ws + WS_LOGF);
    const int tid = F.tid, c = tid >> 4, kg = tid & 15, lane = F.lane, wave = F.wave;
    for (int u = F.vcu; u < 2048 + NSEQ_S; u += F.G) {
        int t0, nvalid, h; unsigned char *qf, *vf, *lf; int qp, lp;
        if (u < 2048) { const int b = u >> 8, n = u & 63; h = (u >> 6) & 3; t0 = b * 2048 + n * 32; nvalid = 32;
            const size_t e0 = (size_t)t0 * DA + h * 128; qf = ws + WS_Q + e0 * 2; vf = ws + WS_V + e0 * 2; lf = ws + WS_LOGF + e0 * 4; qp = 1024; lp = 2048; }
        else { const int su = u - 2048, b = su >> 2; h = su & 3; t0 = TP + b * 8; nvalid = 8;
            unsigned char* base = sfr + (size_t)su * 65536; qf = base; vf = base + 8192; lf = base + 16384; qp = 256; lp = 512; }
        f32x4 lf0 = {0.f, 0.f, 0.f, 0.f}, lf1 = {0.f, 0.f, 0.f, 0.f}; v4u q8 = {0u, 0u, 0u, 0u}, v8 = {0u, 0u, 0u, 0u};
        if (c < nvalid) { const size_t e = (size_t)(t0 + c) * DA + h * 128 + 8 * kg;
            lf0 = NTL((const GAS f32x4*)(LFg + e)); lf1 = NTL((const GAS f32x4*)(LFg + e + 4)); q8 = NTL((const GAS v4u*)(Qg + e)); v8 = NTL((const GAS v4u*)(Vg + e)); }
        VM_WAIT();
        *(LAS f32x4*)(LB + c * 132 + 8 * kg) = lf0; *(LAS f32x4*)(LB + c * 132 + 8 * kg + 4) = lf1;
        { const unsigned vv[4] = {v8.x, v8.y, v8.z, v8.w};
#pragma unroll
          for (int j = 0; j < 4; ++j) { VT[(8 * kg + 2 * j) * 40 + c] = (bf16)(vv[j] & 0xffffu); VT[(8 * kg + 2 * j + 1) * 40 + c] = (bf16)(vv[j] >> 16); } }
        LDSBAR();
        if (tid < 128) { float run = 0.f;
#pragma unroll 8
            for (int cc = 0; cc < 32; ++cc) { run += LB[cc * 132 + tid]; LB[cc * 132 + tid] = run; } }
        LDSBAR();
        {
            const f32x4 b0 = *(LAS f32x4*)(LB + c * 132 + 8 * kg), b1 = *(LAS f32x4*)(LB + c * 132 + 8 * kg + 4);
            const f32x4 e0 = *(LAS f32x4*)(LB + 31 * 132 + 8 * kg), e1 = *(LAS f32x4*)(LB + 31 * 132 + 8 * kg + 4);
            const unsigned qq[4] = {q8.x, q8.y, q8.z, q8.w};
            float qd[8], kd[8], ke[8];
#pragma unroll
            for (int j = 0; j < 8; ++j) { const float lfj = j < 4 ? lf0[j] : lf1[j - 4], bj = j < 4 ? b0[j] : b1[j - 4], blj = j < 4 ? e0[j] : e1[j - 4];
                const float qj = (j & 1) ? bfhi(qq[j >> 1]) : bflo(qq[j >> 1]);
                const float kin = 1.0f - __expf(lfj);
                qd[j] = qj * __expf(bj); kd[j] = kin * __expf(-bj); ke[j] = kin * __expf(blj - bj); }
            v4u w; w.x = pk2(qd[0], qd[1]); w.y = pk2(qd[2], qd[3]); w.z = pk2(qd[4], qd[5]); w.w = pk2(qd[6], qd[7]);
            *(LAS v4u*)(QD + c * 136 + 8 * kg) = w;
            v4u wk; wk.x = pk2(kd[0], kd[1]); wk.y = pk2(kd[2], kd[3]); wk.z = pk2(kd[4], kd[5]); wk.w = pk2(kd[6], kd[7]);
            *(LAS v4u*)(KD + c * 136 + 8 * kg) = wk;
#pragma unroll
            for (int j = 0; j < 8; ++j) KET[(8 * kg + j) * 40 + c] = (bf16)f2bf(ke[j]);
#pragma unroll
            for (int g = 0; g < 2; ++g) { const int g4 = 2 * kg + g, m = g4 >> 3, r8 = g4 & 7, jh = r8 >> 2, q4 = r8 & 3, ch = c >> 4, lp_ = 16 * q4 + (c & 15);
                const int o = (((ch * 4 + m) * 64 + lp_) << 4) + jh * 8;
                v2u x; x.x = g ? w.z : w.x; x.y = g ? w.w : w.y;
                *(GAS v2u*)(qf + (size_t)(o >> 8) * qp + (o & 255)) = x; }
            if (c == 0) { const int o = 10240 + 32 * kg; unsigned char* p = lf + (size_t)(o >> 9) * lp + (o & 511);
                f32x4 d0, d1;
#pragma unroll
                for (int j = 0; j < 4; ++j) { d0[j] = __expf(e0[j]); d1[j] = __expf(e1[j]); }
                *(GAS f32x4*)p = d0; *(GAS f32x4*)(p + 16) = d1; }
        }
        LDSBAR();
        if (wave < 4) {
            const int cb = wave >> 1, sb = wave & 1, r = lane & 15, q = lane >> 4;
            f32x4 a4 = {0.f, 0.f, 0.f, 0.f};
            if (!(cb == 0 && sb == 1)) {
#pragma unroll
                for (int kk = 0; kk < 4; ++kk) { const bf16x8 a = *(LAS bf16x8*)(QD + (16 * cb + r) * 136 + 32 * kk + 8 * q), bb = *(LAS bf16x8*)(KD + (16 * sb + r) * 136 + 32 * kk + 8 * q);
                    a4 = __builtin_amdgcn_mfma_f32_16x16x32_bf16(a, bb, a4, 0, 0, 0); }
            }
#pragma unroll
            for (int i = 0; i < 4; ++i) { const int cc = 16 * cb + 4 * q + i, ss = 16 * sb + r; SC[cc * 40 + ss] = (bf16)f2bf(cc >= ss ? a4[i] : 0.f); }
        } else {
            const int tt = tid - 256;
#pragma unroll
            for (int rep = 0; rep < 2; ++rep) { const int p = tt + 256 * rep, kb = p >> 6, l2 = p & 63, o = p << 4;
                const v4u x = *(LAS v4u*)(KET + (16 * kb + (l2 & 15)) * 40 + 8 * (l2 >> 4));
                *(GAS v4u*)(lf + (size_t)(o >> 9) * lp + (o & 511)) = x;
                const v4u y = *(LAS v4u*)(VT + (16 * kb + (l2 & 15)) * 40 + 8 * (l2 >> 4));
                *(GAS v4u*)(vf + (size_t)(o >> 8) * qp + (o & 255)) = y; }
        }
        LDSBAR();
        if (tid < 128) { const int p = tid, ch = p >> 6, l2 = p & 63, o = 8192 + (p << 4);
            const v4u x = *(LAS v4u*)(SC + (16 * ch + (l2 & 15)) * 40 + 8 * (l2 >> 4));
            *(GAS v4u*)(lf + (size_t)(o >> 9) * lp + (o & 511)) = x; }
        LDSBAR();
    }
}

struct HgPre { v4u q, v, l0, l1; };
constexpr int HG_SLOT = 27648;
__device__ __forceinline__ void hg_chunk(const LAS unsigned char* sl, f32x4 (&S)[8], float* Orow, int nvalid, int vs, int lane) {
    const int r = lane & 15, q = lane >> 4;
    const bf16x8 vfr = *(const LAS bf16x8*)(sl + 16384 + ((vs * 64 + lane) << 4));
    f32x4 o0 = {0.f, 0.f, 0.f, 0.f}, o1 = {0.f, 0.f, 0.f, 0.f};
    { const bf16x8 s0 = *(const LAS bf16x8*)(sl + 24576 + (lane << 4)), s1 = *(const LAS bf16x8*)(sl + 24576 + ((64 + lane) << 4));
      o0 = __builtin_amdgcn_mfma_f32_16x16x32_bf16(s0, vfr, o0, 0, 0, 0); o1 = __builtin_amdgcn_mfma_f32_16x16x32_bf16(s1, vfr, o1, 0, 0, 0); }
#pragma unroll
    for (int m = 0; m < 4; ++m) {
        v4u sw; sw.x = pk2(S[2 * m][0], S[2 * m][1]); sw.y = pk2(S[2 * m][2], S[2 * m][3]); sw.z = pk2(S[2 * m + 1][0], S[2 * m + 1][1]); sw.w = pk2(S[2 * m + 1][2], S[2 * m + 1][3]);
        const bf16x8 sb = __builtin_bit_cast(bf16x8, sw);
        const bf16x8 a0 = *(const LAS bf16x8*)(sl + ((m * 64 + lane) << 4)), a1 = *(const LAS bf16x8*)(sl + (((4 + m) * 64 + lane) << 4));
        o0 = __builtin_amdgcn_mfma_f32_16x16x32_bf16(a0, sb, o0, 0, 0, 0); o1 = __builtin_amdgcn_mfma_f32_16x16x32_bf16(a1, sb, o1, 0, 0, 0);
    }
#pragma unroll
    for (int i = 0; i < 4; ++i) { const int c0 = 4 * q + i;
        if (c0 < nvalid) Orow[(size_t)c0 * DA + 16 * vs + r] = o0[i];
        if (c0 + 16 < nvalid) Orow[(size_t)(c0 + 16) * DA + 16 * vs + r] = o1[i]; }
#pragma unroll
    for (int kb = 0; kb < 8; ++kb) { const f32x4 d = *(const LAS f32x4*)(sl + 26624 + ((16 * kb + 4 * q) << 2));
        const bf16x8 ke = *(const LAS bf16x8*)(sl + 8192 + ((kb * 64 + lane) << 4));
        S[kb] = __builtin_amdgcn_mfma_f32_16x16x32_bf16(ke, vfr, S[kb] * d, 0, 0, 0); }
}
__device__ __forceinline__ void hg_seq(const Frame& F, unsigned char* ws, const float* s0, float* sout, float* Og, int seq, bool sample, int vs_base, int nvs) {
    LAS unsigned char* ring = F.lds;
    const int tid = F.tid, lane = F.lane, vs = vs_base + F.wave, r = lane & 15, q = lane >> 4;
    const bool active = F.wave < nvs, vload = (unsigned)((tid >> 6) - vs_base) < (unsigned)nvs;
    int nch, nvalid, t0, h; const unsigned char *qf, *vf, *lf; int qp, lp; size_t qstep, lstep;
    if (!sample) { const int b = seq >> 2; h = seq & 3; t0 = b * 2048; nch = 64; nvalid = 32; const size_t e0 = (size_t)t0 * DA + h * 128;
        qf = ws + WS_Q + e0 * 2; vf = ws + WS_V + e0 * 2; lf = ws + WS_LOGF + e0 * 4; qp = 1024; lp = 2048; qstep = 32 * 1024; lstep = 32 * 2048; }
    else { const int b = seq >> 2; h = seq & 3; t0 = TP + b * 8; nch = 1; nvalid = 8; const unsigned char* base = (const unsigned char*)sout + (size_t)seq * 65536;
        qf = base; vf = base + 8192; lf = base + 16384; qp = 256; lp = 512; qstep = 0; lstep = 0; }
    const size_t offq = (size_t)(tid >> 4) * qp + (tid & 15) * 16, offl0 = (size_t)(tid >> 5) * lp + (tid & 31) * 16, offl1 = (size_t)(16 + (tid >> 5)) * lp + (tid & 31) * 16, offl1c = tid < 160 ? offl1 : offl0;
    {
    f32x4 S[8];
    if (sample && active) {
#pragma unroll
        for (int kb = 0; kb < 8; ++kb)
#pragma unroll
            for (int i = 0; i < 4; ++i) S[kb][i] = s0[((size_t)seq * 128 + 16 * kb + 4 * q + i) * 128 + 16 * vs + r];
    } else {
#pragma unroll
        for (int kb = 0; kb < 8; ++kb) S[kb] = (f32x4){0.f, 0.f, 0.f, 0.f};
    }
    float* Ob = Og + (size_t)t0 * DA + h * 128;
#define HG_LOAD(R, n) do { if (sample) { if ((n) < nch) { R.q = NTL((const GAS v4u*)(qf + offq)); if (vload) R.v = NTL((const GAS v4u*)(vf + offq)); R.l0 = NTL((const GAS v4u*)(lf + offl0)); if (tid < 160) R.l1 = NTL((const GAS v4u*)(lf + offl1)); } } \
        else { const int n_ = (n) < nch ? (n) : nch - 1; const unsigned char* q_ = qf + (size_t)n_ * qstep; const unsigned char* v_ = vf + (size_t)n_ * qstep; const unsigned char* l_ = lf + (size_t)n_ * lstep; \
        R.q = NTL((const GAS v4u*)(q_ + offq)); R.v = NTL((const GAS v4u*)(v_ + offq)); R.l0 = NTL((const GAS v4u*)(l_ + offl0)); R.l1 = NTL((const GAS v4u*)(l_ + offl1c)); } } while (0)
#define HG_STORE(R, s) do { LAS unsigned char* d_ = ring + (s) * HG_SLOT; *(LAS v4u*)(d_ + 16 * tid) = R.q; if (vload) *(LAS v4u*)(d_ + 16384 + 16 * tid) = R.v; *(LAS v4u*)(d_ + 8192 + 16 * tid) = R.l0; \
        if (tid < 160) *(LAS v4u*)(d_ + 24576 + 16 * tid) = R.l1; } while (0)
    HgPre R0, R1, R2, R3, R4, R5;
    R0.l1 = R0.v = (v4u){0u, 0u, 0u, 0u}; R1.l1 = R1.v = (v4u){0u, 0u, 0u, 0u}; R2.l1 = R2.v = (v4u){0u, 0u, 0u, 0u}; R3.l1 = R3.v = (v4u){0u, 0u, 0u, 0u}; R4.l1 = R4.v = (v4u){0u, 0u, 0u, 0u}; R5.l1 = R5.v = (v4u){0u, 0u, 0u, 0u};
    HG_LOAD(R0, 0); HG_LOAD(R1, 1); HG_LOAD(R2, 2); HG_LOAD(R3, 3); HG_LOAD(R4, 4);
    HG_STORE(R0, 0); LDSBAR();
    for (int n = 0; n < nch; n += 6) {
        HG_LOAD(R5, n + 5); if (active) hg_chunk(ring, S, Ob + (size_t)(n + 0) * 32 * DA, nvalid, vs, lane); if (n + 1 < nch) HG_STORE(R1, 1); LDSBAR(); if (n + 1 >= nch) break;
        HG_LOAD(R0, n + 6); if (active) hg_chunk(ring + HG_SLOT, S, Ob + (size_t)(n + 1) * 32 * DA, nvalid, vs, lane); if (n + 2 < nch) HG_STORE(R2, 0); LDSBAR(); if (n + 2 >= nch) break;
        HG_LOAD(R1, n + 7); if (active) hg_chunk(ring, S, Ob + (size_t)(n + 2) * 32 * DA, nvalid, vs, lane); if (n + 3 < nch) HG_STORE(R3, 1); LDSBAR(); if (n + 3 >= nch) break;
        HG_LOAD(R2, n + 8); if (active) hg_chunk(ring + HG_SLOT, S, Ob + (size_t)(n + 3) * 32 * DA, nvalid, vs, lane); if (n + 4 < nch) HG_STORE(R4, 0); LDSBAR(); if (n + 4 >= nch) break;
        HG_LOAD(R3, n + 9); if (active) hg_chunk(ring, S, Ob + (size_t)(n + 4) * 32 * DA, nvalid, vs, lane); if (n + 5 < nch) HG_STORE(R5, 1); LDSBAR(); if (n + 5 >= nch) break;
        HG_LOAD(R4, n + 10); if (active) hg_chunk(ring + HG_SLOT, S, Ob + (size_t)(n + 5) * 32 * DA, nvalid, vs, lane); if (n + 6 < nch) HG_STORE(R0, 0); LDSBAR();
    }
    if (active) {
#pragma unroll
    for (int kb = 0; kb < 8; ++kb)
#pragma unroll
        for (int i = 0; i < 4; ++i) sout[((size_t)seq * 128 + 16 * kb + 4 * q + i) * 128 + 16 * vs + r] = S[kb][i];
    }
    LDSBAR();
    }
}


#undef HG_LOAD
#undef HG_STORE
struct SgPre { v4u a0, a1, b0, b1; };
template <class Epi>
__device__ __forceinline__ void small_gemm(const Frame& F, const bf16* A, const bf16* Bt, int row_base, int K, const Epi E) {
    constexpr int LDT = 136, BUF = 64 * LDT;
    LAS bf16* As = (LAS bf16*)F.lds; LAS bf16* Bs = As + 2 * BUF;
    const int tid = F.tid, lane = F.lane, w = F.wave, r = lane & 15, q = lane >> 4, prow = tid >> 3, pk = (tid & 7) * 8, ns = K / 128;
    for (int u = F.vcu; u < 256; u += F.G) {
        const int r0 = row_base + (u >> 4) * 64, c0 = (u & 15) * 64;
        const bf16* ap = A + (size_t)(r0 + prow) * K + pk; const bf16* bp = Bt + (size_t)(c0 + prow) * K + pk;
        f32x4 acc0 = {0.f, 0.f, 0.f, 0.f}, acc1 = {0.f, 0.f, 0.f, 0.f};
        const typename Epi::Pre ep0 = E.pre4(r0 + 16 * (w & 3) + r, c0 + 32 * (w >> 2) + 4 * q), ep1 = E.pre4(r0 + 16 * (w & 3) + r, c0 + 32 * (w >> 2) + 16 + 4 * q);
#define SG_LOAD(R, s_) do { if ((s_) < ns) { R.a0 = NTL((const GAS v4u*)(ap + (s_) * 128)); R.a1 = NTL((const GAS v4u*)(ap + (s_) * 128 + 64)); R.b0 = NTL((const GAS v4u*)(bp + (s_) * 128)); R.b1 = NTL((const GAS v4u*)(bp + (s_) * 128 + 64)); } } while (0)
#define SG_STORE(R, b_) do { *(LAS v4u*)(As + (b_) * BUF + prow * LDT + pk) = R.a0; *(LAS v4u*)(As + (b_) * BUF + prow * LDT + pk + 64) = R.a1; *(LAS v4u*)(Bs + (b_) * BUF + prow * LDT + pk) = R.b0; *(LAS v4u*)(Bs + (b_) * BUF + prow * LDT + pk + 64) = R.b1; } while (0)
#define SG_COMP(b_) do { _Pragma("unroll") for (int kk = 0; kk < 4; ++kk) { \
            const bf16x8 a_ = *(const LAS bf16x8*)(As + (b_) * BUF + (16 * (w & 3) + r) * LDT + 32 * kk + 8 * q); \
            const bf16x8 x0_ = *(const LAS bf16x8*)(Bs + (b_) * BUF + (32 * (w >> 2) + r) * LDT + 32 * kk + 8 * q), x1_ = *(const LAS bf16x8*)(Bs + (b_) * BUF + (32 * (w >> 2) + 16 + r) * LDT + 32 * kk + 8 * q); \
            acc0 = __builtin_amdgcn_mfma_f32_16x16x32_bf16(x0_, a_, acc0, 0, 0, 0); acc1 = __builtin_amdgcn_mfma_f32_16x16x32_bf16(x1_, a_, acc1, 0, 0, 0); } } while (0)
        SgPre R0, R1, R2, R3;
        SG_LOAD(R0, 0); SG_LOAD(R1, 1); SG_LOAD(R2, 2);
        SG_STORE(R0, 0); LDSBAR();
        for (int s = 0; s < ns; s += 4) {
            SG_LOAD(R3, s + 3); SG_COMP(0); if (s + 1 < ns) SG_STORE(R1, 1); LDSBAR(); if (s + 1 >= ns) break;
            SG_LOAD(R0, s + 4); SG_COMP(1); if (s + 2 < ns) SG_STORE(R2, 0); LDSBAR(); if (s + 2 >= ns) break;
            SG_LOAD(R1, s + 5); SG_COMP(0); if (s + 3 < ns) SG_STORE(R3, 1); LDSBAR(); if (s + 3 >= ns) break;
            SG_LOAD(R2, s + 6); SG_COMP(1); if (s + 4 < ns) SG_STORE(R0, 0); LDSBAR();
        }
#undef SG_LOAD
#undef SG_STORE
#undef SG_COMP
        { float ss = E.store4p(r0 + 16 * (w & 3) + r, c0 + 32 * (w >> 2) + 4 * q, acc0, ep0);
          ss += E.store4p(r0 + 16 * (w & 3) + r, c0 + 32 * (w >> 2) + 16 + 4 * q, acc1, ep1);
          if (E.has_norm()) {
              LAS float* RS_ = (LAS float*)F.lds;
              ss += __shfl_xor(ss, 16); ss += __shfl_xor(ss, 32);
              if (q == 0) RS_[(w >> 2) * 64 + 16 * (w & 3) + r] = ss;
              LDSBAR();
              if (tid < 64) E.row_store_s(r0 + tid, u & 15, RS_[tid] + RS_[64 + tid]);
              LDSBAR(); } }
    }
}


__device__ __forceinline__ void small_gemm_dual(const Frame& F, const bf16* ZA, const bf16* WA, const bf16* ZB, const bf16* WB, const bf16* SGA, const bf16* SGB, bf16* MG, int row_base) {
    constexpr int K = DA, LDT = 72, ARR = 64 * LDT, BUF = 4 * ARR, ns = K / 64;
    LAS bf16* L = (LAS bf16*)F.lds;
    const int tid = F.tid, lane = F.lane, w = F.wave, r = lane & 15, q = lane >> 4, prow = tid >> 3, pk = (tid & 7) * 8;
    for (int u = F.vcu; u < 256; u += F.G) {
        const int r0 = row_base + (u >> 4) * 64, c0 = (u & 15) * 64;
        const bf16* a1p = ZA + (size_t)(r0 + prow) * K + pk; const bf16* b1p = WA + (size_t)(c0 + prow) * K + pk;
        const bf16* a2p = ZB + (size_t)(r0 + prow) * K + pk; const bf16* b2p = WB + (size_t)(c0 + prow) * K + pk;
        const int orow = r0 + 16 * (w & 3) + r, ocol = c0 + 32 * (w >> 2) + 4 * q;
        const size_t o0 = (size_t)orow * DM + ocol, o1 = o0 + 16;
        const v2u ga0 = NTL((const GAS v2u*)(SGA + o0)), ga1 = NTL((const GAS v2u*)(SGA + o1)), gb0 = NTL((const GAS v2u*)(SGB + o0)), gb1 = NTL((const GAS v2u*)(SGB + o1));
        f32x4 aa0 = {0.f, 0.f, 0.f, 0.f}, aa1 = aa0, ab0 = aa0, ab1 = aa0;
#define SD_LOAD(R, s_) do { const int c_ = (s_) < ns ? (s_) : ns - 1; R.a0 = NTL((const GAS v4u*)(a1p + c_ * 64)); R.a1 = NTL((const GAS v4u*)(b1p + c_ * 64)); R.b0 = NTL((const GAS v4u*)(a2p + c_ * 64)); R.b1 = NTL((const GAS v4u*)(b2p + c_ * 64)); } while (0)
#define SD_STORE(R, b_) do { LAS bf16* d_ = L + (b_) * BUF + prow * LDT + pk; *(LAS v4u*)(d_) = R.a0; *(LAS v4u*)(d_ + ARR) = R.a1; *(LAS v4u*)(d_ + 2 * ARR) = R.b0; *(LAS v4u*)(d_ + 3 * ARR) = R.b1; } while (0)
#define SD_COMP(b_) do { const LAS bf16* s_ = L + (b_) * BUF; _Pragma("unroll") for (int kk = 0; kk < 2; ++kk) { const int ko_ = 32 * kk + 8 * q; \
            const bf16x8 a1_ = *(const LAS bf16x8*)(s_ + (16 * (w & 3) + r) * LDT + ko_), a2_ = *(const LAS bf16x8*)(s_ + 2 * ARR + (16 * (w & 3) + r) * LDT + ko_); \
            const bf16x8 x10_ = *(const LAS bf16x8*)(s_ + ARR + (32 * (w >> 2) + r) * LDT + ko_), x11_ = *(const LAS bf16x8*)(s_ + ARR + (32 * (w >> 2) + 16 + r) * LDT + ko_); \
            const bf16x8 x20_ = *(const LAS bf16x8*)(s_ + 3 * ARR + (32 * (w >> 2) + r) * LDT + ko_), x21_ = *(const LAS bf16x8*)(s_ + 3 * ARR + (32 * (w >> 2) + 16 + r) * LDT + ko_); \
            aa0 = __builtin_amdgcn_mfma_f32_16x16x32_bf16(x10_, a1_, aa0, 0, 0, 0); aa1 = __builtin_amdgcn_mfma_f32_16x16x32_bf16(x11_, a1_, aa1, 0, 0, 0); \
            ab0 = __builtin_amdgcn_mfma_f32_16x16x32_bf16(x20_, a2_, ab0, 0, 0, 0); ab1 = __builtin_amdgcn_mfma_f32_16x16x32_bf16(x21_, a2_, ab1, 0, 0, 0); } } while (0)
        SgPre R0, R1, R2, R3;
        SD_LOAD(R0, 0); SD_LOAD(R1, 1); SD_LOAD(R2, 2);
        SD_STORE(R0, 0); LDSBAR();
        for (int s = 0; s < ns; s += 4) {
            SD_LOAD(R3, s + 3); SD_COMP(0); if (s + 1 < ns) SD_STORE(R1, 1); LDSBAR(); if (s + 1 >= ns) break;
            SD_LOAD(R0, s + 4); SD_COMP(1); if (s + 2 < ns) SD_STORE(R2, 0); LDSBAR(); if (s + 2 >= ns) break;
            SD_LOAD(R1, s + 5); SD_COMP(0); if (s + 3 < ns) SD_STORE(R3, 1); LDSBAR(); if (s + 3 >= ns) break;
            SD_LOAD(R2, s + 6); SD_COMP(1); if (s + 4 < ns) SD_STORE(R0, 0); LDSBAR();
        }
#undef SD_LOAD
#undef SD_STORE
#undef SD_COMP
        { v2u w0; w0.x = pk2(bflo(ga0.x) * aa0[0] + bflo(gb0.x) * ab0[0], bfhi(ga0.x) * aa0[1] + bfhi(gb0.x) * ab0[1]); w0.y = pk2(bflo(ga0.y) * aa0[2] + bflo(gb0.y) * ab0[2], bfhi(ga0.y) * aa0[3] + bfhi(gb0.y) * ab0[3]);
          *(GAS v2u*)(MG + o0) = w0;
          v2u w1; w1.x = pk2(bflo(ga1.x) * aa1[0] + bflo(gb1.x) * ab1[0], bfhi(ga1.x) * aa1[1] + bfhi(gb1.x) * ab1[1]); w1.y = pk2(bflo(ga1.y) * aa1[2] + bflo(gb1.y) * ab1[2], bfhi(ga1.y) * aa1[3] + bfhi(gb1.y) * ab1[3]);
          *(GAS v2u*)(MG + o1) = w1; }
    }
}

__device__ __forceinline__ void zb_rows(unsigned char* ws, const float* cw, const float* st_c, float* out, int lane, int gw, int NGW) {
    bf16* BGb = (bf16*)(ws + WS_BG); const bf16* Ub = (const bf16*)(ws + WS_U);
    const int hl = lane & 31, hw = lane >> 5, c0 = 16 * hl;
    for (int t = 2 * gw + hw; t < T; t += 2 * NGW) {
        const bool smp = t >= TP; const int pos = smp ? ((t - TP) & 7) : (t & 2047), L = smp ? 8 : 2048, bb = smp ? ((t - TP) >> 3) : (t >> 11);
        const size_t e = (size_t)t * DA + c0;
        v4u bg[2], u0[2], x1[2], x2[2];
#pragma unroll
        for (int h = 0; h < 2; ++h) { bg[h] = NTL((const GAS v4u*)(BGb + e + 8 * h)); u0[h] = NTL((const GAS v4u*)(Ub + e + 8 * h));
            x1[h] = (pos >= 1) ? NTL((const GAS v4u*)(Ub + e - DA + 8 * h)) : (v4u){0u, 0u, 0u, 0u};
            x2[h] = (pos >= 2) ? NTL((const GAS v4u*)(Ub + e - 2 * DA + 8 * h)) : (v4u){0u, 0u, 0u, 0u}; }
#pragma unroll
        for (int h = 0; h < 2; ++h) {
            float um1[8], um2[8];
            { const v4u x = x1[h]; um1[0] = bflo(x.x); um1[1] = bfhi(x.x); um1[2] = bflo(x.y); um1[3] = bfhi(x.y); um1[4] = bflo(x.z); um1[5] = bfhi(x.z); um1[6] = bflo(x.w); um1[7] = bfhi(x.w); }
            { const v4u x = x2[h]; um2[0] = bflo(x.x); um2[1] = bfhi(x.x); um2[2] = bflo(x.y); um2[3] = bfhi(x.y); um2[4] = bflo(x.z); um2[5] = bfhi(x.z); um2[6] = bflo(x.w); um2[7] = bfhi(x.w); }
            if (smp && pos < 1) { const size_t so = ((size_t)bb * 2 + 1) * DA + c0 + 8 * h; const f32x4 a = *(const GAS f32x4*)(st_c + so), b = *(const GAS f32x4*)(st_c + so + 4);
                um1[0] = a.x; um1[1] = a.y; um1[2] = a.z; um1[3] = a.w; um1[4] = b.x; um1[5] = b.y; um1[6] = b.z; um1[7] = b.w; }
            if (smp && pos < 2) { const size_t so = ((size_t)bb * 2 + pos) * DA + c0 + 8 * h; const f32x4 a = *(const GAS f32x4*)(st_c + so), b = *(const GAS f32x4*)(st_c + so + 4);
                um2[0] = a.x; um2[1] = a.y; um2[2] = a.z; um2[3] = a.w; um2[4] = b.x; um2[5] = b.y; um2[6] = b.z; um2[7] = b.w; }
            const unsigned uw[4] = {u0[h].x, u0[h].y, u0[h].z, u0[h].w}, bw[4] = {bg[h].x, bg[h].y, bg[h].z, bg[h].w};
            const f32x4 w0a = *(const GAS f32x4*)(cw + c0 + 8 * h), w0b = *(const GAS f32x4*)(cw + c0 + 8 * h + 4), w1a = *(const GAS f32x4*)(cw + DA + c0 + 8 * h), w1b = *(const GAS f32x4*)(cw + DA + c0 + 8 * h + 4),
                        w2a = *(const GAS f32x4*)(cw + 2 * DA + c0 + 8 * h), w2b = *(const GAS f32x4*)(cw + 2 * DA + c0 + 8 * h + 4);
            float zb[8], uf[8];
#pragma unroll
            for (int j = 0; j < 8; ++j) { uf[j] = (j & 1) ? bfhi(uw[j >> 1]) : bflo(uw[j >> 1]); const float bgj = (j & 1) ? bfhi(bw[j >> 1]) : bflo(bw[j >> 1]);
                const float w0 = j < 4 ? w0a[j & 3] : w0b[j & 3], w1 = j < 4 ? w1a[j & 3] : w1b[j & 3], w2 = j < 4 ? w2a[j & 3] : w2b[j & 3];
                zb[j] = bgj * (w0 * um2[j] + w1 * um1[j] + w2 * uf[j]); }
            v4u zw; zw.x = pk2(zb[0], zb[1]); zw.y = pk2(zb[2], zb[3]); zw.z = pk2(zb[4], zb[5]); zw.w = pk2(zb[6], zb[7]);
            *(GAS v4u*)(BGb + e + 8 * h) = zw;
            if (pos >= L - 2) { float* so = out + (smp ? OUT_SCS : OUT_SCP) + ((size_t)bb * 2 + (pos - (L - 2))) * DA + c0 + 8 * h;
                *(GAS f32x4*)so = (f32x4){uf[0], uf[1], uf[2], uf[3]}; *(GAS f32x4*)(so + 4) = (f32x4){uf[4], uf[5], uf[6], uf[7]}; }
        }
    }
}


__device__ __forceinline__ int unit_pm_n5632(int L) { const int wgid = (L % 8) * 187 + L / 8, gid = wgid / 176, fm = gid * 8, gsz = (68 - fm) < 8 ? (68 - fm) : 8; return fm + ((wgid % 176) % gsz); }
__device__ __forceinline__ void rstd_prefetch(const Frame& F, const float* PP, const float* PS) {
    LAS int* PMT = (LAS int*)(F.lds + PMT_OFF); LAS float* RSL = (LAS float*)(F.lds + RSL_OFF);
    for (int i = 0; i < RSL_SLOTS; ++i) { const int L = i * F.G + (int)blockIdx.x; const bool ok = (L < 1496) && (F.G % 8 == 0);
        const int pm = ok ? unit_pm_n5632(L) : -1;
        if (ok && F.tid < 256) RSL[i * 256 + F.tid] = pg8::row_rstd(PP, PS, pm * 256 + F.tid);
        if (F.tid == 0) PMT[i] = pm; }
    __syncthreads();
}

__global__ void __launch_bounds__(NWAVES * 64, 2) mk_fwd(Args args) {
    extern __shared__ __attribute__((aligned(16))) unsigned char lds[];
    Frame F;
    F.lds = (LAS unsigned char*)lds;
    F.MISC = (volatile LAS unsigned*)(F.lds + MISC_OFF);
    F.tid = threadIdx.x; F.lane = F.tid & 63; F.wave = __builtin_amdgcn_readfirstlane(F.tid >> 6);
    F.G = gridDim.x; { const int bx = blockIdx.x; F.vcu = (F.G % 8 == 0) ? (bx % 8) * (F.G / 8) + bx / 8 : bx; }
    unsigned char* ws = args.ws;
    F.ctl = (gu32*)(ws + WS_CTL);
    for (int u = F.tid; u < (LDS_BYTES - LDSCTL_OFF) / 4; u += NWAVES * 64) ((LAS unsigned*)(F.lds + LDSCTL_OFF))[u] = 0u;
    __syncthreads();
    XcdBarrier bar = xcd_barrier_post((unsigned*)(F.ctl + CW_BAR), F.MISC + 8);
#define GRID_BAR() do { xcd_barrier(bar); REFRESH(); } while (0)
    float* out = args.out;
    bf16* XN = (bf16*)(ws + WS_XN); bf16* Hb = (bf16*)(ws + WS_H);
    const int NGW = F.G * NWAVES;
    const unsigned phmask = args.mask;
    const int first_idle = 1496 % F.G, n_idle = first_idle ? F.G - first_idle : F.G, my_idle = first_idle ? (int)blockIdx.x - first_idle : (int)blockIdx.x;
    const int INGW = n_idle * NWAVES;
#define IGW_ (my_idle * NWAVES + F.wave)
#if defined(PROBE_F) || defined(PROBE_G)
    int probe_two = 2; asm volatile("" : "+s"(probe_two));
#endif
#define GW_ (F.vcu * NWAVES + F.wave)
#define PARTP_ ((float*)(ws + WS_PARTP))
#define PARTS_ ((float*)(ws + WS_PARTS))
#define SCR_ ((LAS float*)(F.lds + F.wave * 16384))
#define REFRESH() do { int t_ = threadIdx.x; asm volatile("" : "+v"(t_)); F.tid = t_; F.lane = t_ & 63; F.wave = __builtin_amdgcn_readfirstlane(t_ >> 6); } while (0)

    if (phmask & (1u << 0)) {
#ifdef PROBE_C
    for (int rep_ = 0; rep_ < 3; ++rep_)
#endif
    {
        conv_w13(kin(6), kin(7), nullptr, ws, SCR_, F.lane, GW_, NGW);
        conv_w2(kin(8), ws, SCR_, F.lane, (GW_ + NGW / 4) % NGW, NGW);
        { const float* win = kin(10); bf16* WIN = (bf16*)(ws + WS_WIN);
          conv_mat(win, nullptr, NIN, DM, 2560, WIN, 0, 0, SCR_, F.lane, (GW_ + NGW / 2) % NGW, NGW);
          conv_mat(win + 2560, nullptr, NIN, DM, 512, WIN, 1, 2560, SCR_, F.lane, (GW_ + NGW / 8) % NGW, NGW);
          conv_mat(win + 3072, nullptr, NIN, DM, 512, WIN, 1, 2560 + 16, SCR_, F.lane, (GW_ + 3 * (NGW / 8)) % NGW, NGW);
          conv_mat(win + 3584, nullptr, NIN, DM, 2048, WIN, 0, 3584, SCR_, F.lane, (GW_ + 3 * (NGW / 4)) % NGW, NGW); }
        { const float* xp = kin(0); const float* xs = kin(1); const float* g1 = kin(5);
          for (int m = 2 * GW_; m < T; m += 2 * NGW) { const float* ra = m < TP ? xp + (size_t)m * DM : xs + (size_t)(m - TP) * DM;
              rms_row2_bf16(ra, ra + DM, g1, XN + (size_t)m * DM, XN + (size_t)(m + 1) * DM, F.lane); } }
    }
    GRID_BAR();
#ifdef PROBE_E
    for (int rep_ = 0; rep_ < 10; ++rep_) GRID_BAR();
#endif
#if defined(PROBE_E2) || defined(PROBE_E3) || defined(PROBE_E4) || defined(PROBE_E5)
    for (int rep_ = 0; rep_ < 10; ++rep_) xcd_barrier_probe(bar);
#endif
    }

    if (phmask & (1u << 1)) {
#ifdef PROBE_F
    _Pragma("clang loop unroll(disable)") for (int rep_ = 0; rep_ < probe_two; ++rep_)
#endif
    { pg8::Gemm g{XN, (const bf16*)(ws + WS_W13), T, 2 * DFF, DM}; pg8::StaticOrder S; S.init(T, 2 * DFF, F.G, (int)blockIdx.x);
      pg8::EpiSwiglu E{Hb, DFF, nullptr, nullptr, F.lds}; pg8::gemm_phase<pg8::EpiSwiglu, pg8::StaticOrder, true, true>(F.lds, g, S, E); }
    GRID_BAR();
    }

    if (phmask & (1u << 2)) {
#ifdef PROBE_G
    _Pragma("clang loop unroll(disable)") for (int rep_ = 0; rep_ < probe_two; ++rep_)
#endif
    { pg8::Gemm g{Hb, (const bf16*)(ws + WS_W2), TP, DM, DFF}; pg8::StaticOrder S; S.init(TP, DM, F.G, (int)blockIdx.x);
      pg8::EpiRes<true> E{kin(0), kin(1), out, XN, PARTP_, PARTS_, F.lds, kin(9)};
      if ((blockIdx.x >> 3) & 1) { small_gemm(F, Hb, (const bf16*)(ws + WS_W2), TP, DFF, pg8::EpiRes<true>{kin(0), kin(1), out, XN, PARTP_, PARTS_, F.lds, kin(9)}); REFRESH(); pg8::gemm_phase<pg8::EpiRes<true>, pg8::StaticOrder, true, true>(F.lds, g, S, E); }
      else { pg8::gemm_phase<pg8::EpiRes<true>, pg8::StaticOrder, true, true>(F.lds, g, S, E); REFRESH(); small_gemm(F, Hb, (const bf16*)(ws + WS_W2), TP, DFF, pg8::EpiRes<true>{kin(0), kin(1), out, XN, PARTP_, PARTS_, F.lds, kin(9)}); } }
    GRID_BAR();
    }

    if (phmask & (1u << 3)) {
    rstd_prefetch(F, PARTP_, PARTS_);
    { pg8::Gemm g{XN, (const bf16*)(ws + WS_WIN), T, NIN, DM}; pg8::StaticOrder S; S.init(T, NIN, F.G, (int)blockIdx.x);
      pg8::EpiMix E{(bf16*)(ws + WS_Q), (bf16*)(ws + WS_V), (bf16*)(ws + WS_OG), (bf16*)(ws + WS_BG), (bf16*)(ws + WS_U), (bf16*)(ws + WS_SGA), (bf16*)(ws + WS_SGB), (float*)(ws + WS_LOGF), kin(4), PARTP_, PARTS_, F.lds};
      pg8::gemm_phase<pg8::EpiMix, pg8::StaticOrder, true, true>(F.lds, g, S, E); }
    GRID_BAR();
    }

    if (phmask & (1u << 4)) {
    hg_prep(F, ws, (unsigned char*)(out + OUT_SHS));
    GRID_BAR();
    }

    if (phmask & (1u << 5)) {
    {
        float* Og = (float*)(ws + WS_XN); const float* st_h = kin(2); const float* st_c = kin(3);
        const int bid = (int)blockIdx.x, G = F.G;
        constexpr int NSCAN = 4 * NSEQ_P;
        if (G >= 2 * NSCAN) {
            for (int s = bid; s < NSEQ_S; s += G) hg_seq(F, ws, st_h, out + OUT_SHS, Og, s, true, 0, 8);
            if (bid < NSCAN) hg_seq(F, ws, nullptr, out + OUT_SHP, Og, bid >> 2, false, 2 * (bid & 3), 2);
            else {
                REFRESH();
                const int cgw = (bid - NSCAN) * NWAVES + F.wave, CNGW = (G - NSCAN) * NWAVES;
                zb_rows(ws, kin(11), st_c, out, F.lane, cgw, CNGW);
                conv_mat(kin(13), nullptr, DM, DA, DM, (bf16*)(ws + WS_WA), 0, 0, SCR_, F.lane, cgw, CNGW);
                conv_mat(kin(14), nullptr, DM, DA, DM, (bf16*)(ws + WS_WB), 0, 0, SCR_, F.lane, (cgw + CNGW / 4) % CNGW, CNGW);
                conv_mat(kin(15), nullptr, DM, DM, DM, (bf16*)(ws + WS_WO), 0, 0, SCR_, F.lane, (cgw + CNGW / 2) % CNGW, CNGW);
                conv_w13(kin(17), kin(18), nullptr, ws, SCR_, F.lane, cgw, CNGW);
                conv_w2(kin(19), ws, SCR_, F.lane, (cgw + CNGW / 3) % CNGW, CNGW);
            }
        } else {
            for (int s = bid; s < NSEQ_P; s += G) hg_seq(F, ws, nullptr, out + OUT_SHP, Og, s, false, 0, 8);
            for (int s = bid; s < NSEQ_S; s += G) hg_seq(F, ws, st_h, out + OUT_SHS, Og, s, true, 0, 8);
            REFRESH();
            zb_rows(ws, kin(11), st_c, out, F.lane, GW_, NGW);
            conv_mat(kin(13), nullptr, DM, DA, DM, (bf16*)(ws + WS_WA), 0, 0, SCR_, F.lane, GW_, NGW);
            conv_mat(kin(14), nullptr, DM, DA, DM, (bf16*)(ws + WS_WB), 0, 0, SCR_, F.lane, GW_, NGW);
            conv_mat(kin(15), nullptr, DM, DM, DM, (bf16*)(ws + WS_WO), 0, 0, SCR_, F.lane, GW_, NGW);
            conv_w13(kin(17), kin(18), nullptr, ws, SCR_, F.lane, GW_, NGW);
            conv_w2(kin(19), ws, SCR_, F.lane, GW_, NGW);
        }
    }
    GRID_BAR();
    }

    if (phmask & (1u << 6)) {
#ifdef PROBE_D
    for (int rep_ = 0; rep_ < 3; ++rep_)
#endif
    {
        const float* Og = (const float*)(ws + WS_XN); const bf16* OGb = (const bf16*)(ws + WS_OG); bf16* ZA = (bf16*)(ws + WS_ZA);
        const float* gh = kin(12);
        const int hl = F.lane & 31, hw = F.lane >> 5, c0 = 16 * hl;
        f32x4 gg[4];
#pragma unroll
        for (int j = 0; j < 4; ++j) gg[j] = *(const GAS f32x4*)(gh + c0 + 4 * j);
        for (int t = 2 * GW_ + hw; t < T; t += 2 * NGW) {
            const size_t e = (size_t)t * DA + c0;
            f32x4 o[4]; v4u og[2];
#pragma unroll
            for (int j = 0; j < 4; ++j) o[j] = NTL((const GAS f32x4*)(Og + e + 4 * j));
            og[0] = NTL((const GAS v4u*)(OGb + e)); og[1] = NTL((const GAS v4u*)(OGb + e + 8));
            float ss = 0.f;
#pragma unroll
            for (int j = 0; j < 4; ++j) ss += (o[j].x * o[j].x + o[j].y * o[j].y) + (o[j].z * o[j].z + o[j].w * o[j].w);
            ss += __shfl_xor(ss, 1); ss += __shfl_xor(ss, 2); ss += __shfl_xor(ss, 4);
            const float rstd = 1.f / sqrtf(ss * (1.f / 128.f) + EPS);
#pragma unroll
            for (int h = 0; h < 2; ++h) { const f32x4 a = o[2 * h] * rstd * gg[2 * h], b = o[2 * h + 1] * rstd * gg[2 * h + 1]; const v4u g8 = og[h];
                v4u za; za.x = pk2(a.x * bflo(g8.x), a.y * bfhi(g8.x)); za.y = pk2(a.z * bflo(g8.y), a.w * bfhi(g8.y)); za.z = pk2(b.x * bflo(g8.z), b.y * bfhi(g8.z)); za.w = pk2(b.z * bflo(g8.w), b.w * bfhi(g8.w));
                *(GAS v4u*)(ZA + e + 8 * h) = za; }
        }
    }
    GRID_BAR();
    }

    if (phmask & (1u << 7)) {
    {
      const bool small_first = ((blockIdx.x >> 3) & 1) != 0;
      if (small_first) { small_gemm_dual(F, (const bf16*)(ws + WS_ZA), (const bf16*)(ws + WS_WA), (const bf16*)(ws + WS_BG), (const bf16*)(ws + WS_WB), (const bf16*)(ws + WS_SGA), (const bf16*)(ws + WS_SGB), (bf16*)(ws + WS_MG), TP); REFRESH(); }
      { pg8::Gemm g{(const bf16*)(ws + WS_ZA), (const bf16*)(ws + WS_WA), TP, DM, DA}; pg8::StaticOrder S; S.init(TP, DM, F.G, (int)blockIdx.x);
        pg8::EpiGate<0> E{(const bf16*)(ws + WS_SGA), (bf16*)(ws + WS_MG)}; pg8::gemm_phase<pg8::EpiGate<0>, pg8::StaticOrder, true, true>(F.lds, g, S, E); }
      VM_WAIT();
      { pg8::Gemm g{(const bf16*)(ws + WS_BG), (const bf16*)(ws + WS_WB), TP, DM, DA}; pg8::StaticOrder S; S.init(TP, DM, F.G, (int)blockIdx.x);
        pg8::EpiGate<1> E{(const bf16*)(ws + WS_SGB), (bf16*)(ws + WS_MG)}; pg8::gemm_phase<pg8::EpiGate<1>, pg8::StaticOrder, true, true>(F.lds, g, S, E); }
      if (!small_first) { REFRESH(); small_gemm_dual(F, (const bf16*)(ws + WS_ZA), (const bf16*)(ws + WS_WA), (const bf16*)(ws + WS_BG), (const bf16*)(ws + WS_WB), (const bf16*)(ws + WS_SGA), (const bf16*)(ws + WS_SGB), (bf16*)(ws + WS_MG), TP); }
    }
    GRID_BAR();
    }

    if (phmask & (1u << 8)) {
    { pg8::Gemm g{(const bf16*)(ws + WS_MG), (const bf16*)(ws + WS_WO), TP, DM, DM}; pg8::StaticOrder S; S.init(TP, DM, F.G, (int)blockIdx.x);
      pg8::EpiRes<false> E{out, out + (size_t)TP * DM, out, XN, PARTP_, PARTS_, F.lds, kin(16)};
      if ((blockIdx.x >> 3) & 1) { small_gemm(F, (const bf16*)(ws + WS_MG), (const bf16*)(ws + WS_WO), TP, DM, pg8::EpiRes<false>{out, out + (size_t)TP * DM, out, XN, PARTP_, PARTS_, F.lds, kin(16)}); REFRESH(); pg8::gemm_phase<pg8::EpiRes<false>, pg8::StaticOrder, true, true>(F.lds, g, S, E); }
      else { pg8::gemm_phase<pg8::EpiRes<false>, pg8::StaticOrder, true, true>(F.lds, g, S, E); REFRESH(); small_gemm(F, (const bf16*)(ws + WS_MG), (const bf16*)(ws + WS_WO), TP, DM, pg8::EpiRes<false>{out, out + (size_t)TP * DM, out, XN, PARTP_, PARTS_, F.lds, kin(16)}); } }
    GRID_BAR();
    }

    if (phmask & (1u << 9)) {
    rstd_prefetch(F, PARTP_, PARTS_);
    { pg8::Gemm g{XN, (const bf16*)(ws + WS_W13), T, 2 * DFF, DM}; pg8::StaticOrder S; S.init(T, 2 * DFF, F.G, (int)blockIdx.x);
      pg8::EpiSwiglu E{Hb, DFF, PARTP_, PARTS_, F.lds}; pg8::gemm_phase<pg8::EpiSwiglu, pg8::StaticOrder, true, true>(F.lds, g, S, E); }
    GRID_BAR();
    { pg8::Gemm g{Hb, (const bf16*)(ws + WS_W2), TP, DM, DFF}; pg8::StaticOrder S; S.init(TP, DM, F.G, (int)blockIdx.x);
      pg8::EpiRes<true> E{out, out + (size_t)TP * DM, out, nullptr, nullptr, nullptr, F.lds, nullptr};
      if ((blockIdx.x >> 3) & 1) { small_gemm(F, Hb, (const bf16*)(ws + WS_W2), TP, DFF, pg8::EpiRes<true>{out, out + (size_t)TP * DM, out, nullptr, nullptr, nullptr, F.lds, nullptr}); REFRESH(); pg8::gemm_phase<pg8::EpiRes<true>, pg8::StaticOrder, true, true>(F.lds, g, S, E); }
      else { pg8::gemm_phase<pg8::EpiRes<true>, pg8::StaticOrder, true, true>(F.lds, g, S, E); REFRESH(); small_gemm(F, Hb, (const bf16*)(ws + WS_W2), TP, DFF, pg8::EpiRes<true>{out, out + (size_t)TP * DM, out, nullptr, nullptr, nullptr, F.lds, nullptr}); } }
    GRID_BAR();
    }

    if (phmask & (1u << 10)) {
    { const float* gg_ = kin(20); for (int m = 2 * GW_; m < T; m += 2 * NGW) rms_row2_f32(out + (size_t)m * DM, gg_, F.lane, m + 1 < T); }
    }
#undef GW_
#undef PARTP_
#undef PARTS_
#undef SCR_
#undef IGW_
#undef REFRESH
}

extern "C" void kernel_launch(void* const* d_in, const int* in_sizes, int n_in, void* d_out, int out_size, void* d_ws, size_t ws_size, hipStream_t stream) {
    static int grid = 0;
    if (grid == 0) {
        if (n_in != 21 || in_sizes[0] != TP * DM || (size_t)out_size != OUT_END || ws_size < WS_END) { fprintf(stderr, "kernel_launch: unexpected shapes (n_in %d, in0 %d, out %d, ws %zu)\n", n_in, n_in > 0 ? in_sizes[0] : -1, out_size, ws_size); grid = -1; return; }
        int dev = 0, cus = 0, per_cu = 0;
        if (hipGetDevice(&dev) != hipSuccess || hipDeviceGetAttribute(&cus, hipDeviceAttributeMultiprocessorCount, dev) != hipSuccess) { grid = -1; return; }
        if (hipFuncSetAttribute((const void*)mk_fwd, hipFuncAttributeMaxDynamicSharedMemorySize, LDS_BYTES) != hipSuccess) { fprintf(stderr, "kernel_launch: hipFuncSetAttribute failed\n"); grid = -1; return; }
        if (hipOccupancyMaxActiveBlocksPerMultiprocessor(&per_cu, (const void*)mk_fwd, NWAVES * 64, LDS_BYTES) != hipSuccess || per_cu < 1) { fprintf(stderr, "kernel_launch: occupancy query says %d blocks per CU\n", per_cu); }
        (void)hipGetLastError();
        grid = cus;
    }
    if (grid < 0) return;
    if (hipMemsetAsync((char*)d_ws + WS_CTL, 0, CTL_ZERO_BYTES, stream) != hipSuccess) return;
    Args a{};
    for (int i = 0; i < 21; ++i) a.in[i] = (const float*)d_in[i];
    a.out = (float*)d_out; a.ws = (unsigned char*)d_ws; a.mask = 0x0000ffffu; a.pad = 0u;
    hipLaunchKernelGGL(mk_fwd, dim3(grid), dim3(NWAVES * 64), LDS_BYTES, stream, a);
#ifdef PROBE_PHASE
    (void)hipMemsetAsync((char*)d_ws + WS_CTL, 0, CTL_ZERO_BYTES, stream);
    a.mask = (PROBE_PHASE);
    hipLaunchKernelGGL(mk_fwd, dim3(grid), dim3(NWAVES * 64), LDS_BYTES, stream, a);
#endif
}
```

```cpp
#include <hip/hip_runtime.h>
#include <cstdio>
#include <cstdint>
namespace pg8 {
#define PG8_LAS __attribute__((address_space(3)))
typedef unsigned short bf16_t;
typedef short bf16x8 __attribute__((ext_vector_type(8)));
typedef float f32x4 __attribute__((ext_vector_type(4)));
typedef unsigned u32x4 __attribute__((ext_vector_type(4)));
constexpr int BM = 256, BK = 64, HALF = 128, HTB = HALF * BK * 2  , STAGE_BYTES = 8 * HTB, NXCD = 8, WGM = 8;

__host__ __device__ __forceinline__ int lds_byte(int r, int c) { const int st = (r >> 4) * 2 + (c >> 5), rr = r & 15, cc = c & 31, ob = rr * 64 + cc * 2; return st * 1024 + (ob ^ (((ob >> 9) & 1) << 5)); }
__host__ __device__ __forceinline__ void stage_rc(int b, int& R, int& C) { const int st = b / 1024, sb = b % 1024, swz = sb ^ (((sb >> 9) & 1) << 5); R = (st >> 1) * 16 + swz / 64; C = (st & 1) * 32 + (swz % 64) / 2; }
__host__ __device__ __forceinline__ int perm32(int rho) { const int n = rho >> 4, i = rho & 15; return 8 * (i >> 2) + 4 * n + (i & 3); }

struct Unit { int pm, pn; };
struct Gemm { const bf16_t* A; const bf16_t* Bt; int M, N, K; };

struct StaticOrder {
    int nM, nN, nwg, G, c;
    __host__ __device__ void init(int M, int N, int G_, int c_) { nM = M / BM; nN = N / BM; nwg = nM * nN; G = G_; c = c_; }
    __host__ __device__ bool next(int i, Unit& u) const {
        const long L = (long)i * G + c; if (L >= nwg) return false;
        int wgid = (int)L; { const int q = nwg / NXCD, r = nwg % NXCD, xcd = wgid % NXCD, off = wgid / NXCD; wgid = (xcd < r ? xcd * (q + 1) : r * (q + 1) + (xcd - r) * q) + off; }
        const int nig = WGM * nN, gid = wgid / nig, fm = gid * WGM, gsz = (nM - fm) < WGM ? (nM - fm) : WGM;
        u.pm = fm + ((wgid % nig) % gsz); u.pn = (wgid % nig) / gsz; return true;
    }
    __device__ __forceinline__ void a_ready(const Unit&) const {}
    __device__ __forceinline__ void done(const Unit&) const {}
};

__device__ __forceinline__ unsigned cvt_pk_bf16(float lo, float hi) { unsigned r; asm volatile("v_cvt_pk_bf16_f32 %0, %1, %2" : "=v"(r) : "v"(lo), "v"(hi)); return r; }

template <class Epi, class Sched, bool ALIGN_EPI = false, bool SP2 = false>
__device__ __forceinline__ void gemm_phase(PG8_LAS unsigned char* lds, const Gemm g, const Sched& S, const Epi& E) {
    const int tid = threadIdx.x, wid = __builtin_amdgcn_readfirstlane(tid >> 6), lane = tid & 63, wr = wid >> 2, wc = wid & 3, fr = lane & 15, fq = lane >> 4;
    const int K = g.K, nt = K / BK;
    unsigned voffA[2], voffB[2];
#pragma unroll
    for (int i = 0; i < 2; ++i) { int R, C; stage_rc(tid * 16 + i * 8192, R, C); const int Rb = Epi::PERM ? ((R & ~31) + perm32(R & 31)) : R;
        voffA[i] = (unsigned)(R * K + C) * 2u; voffB[i] = (unsigned)(Rb * K + C) * 2u; }
    const size_t kstep = (size_t)(BK * 2);
    const size_t hstep = (size_t)HALF * K * 2;
    const size_t tstep = 2 * hstep;
    const unsigned ldsw = (unsigned)wid * 1024u;
    const int aoff = lds_byte(wr * 64 + fr, fq * 8), boff = lds_byte(wc * 32 + fr, fq * 8);
#define PG8_SA(b, h) (((b) * 2 + (h)) * HTB)
#define PG8_SB(b, h) ((4 + (b) * 2 + (h)) * HTB)
#define PG8_STAGE(bufoff, gbase, voff) do { _Pragma("unroll") for (int _i = 0; _i < 2; ++_i) \
        __builtin_amdgcn_global_load_lds((const unsigned*)((const char*)(gbase) + (voff)[_i]), (PG8_LAS unsigned*)(lds + (bufoff) + ldsw + _i * 8192), 16, 0, 0); } while (0)
#define PG8_LDA(dst, b, h) do { _Pragma("unroll") for (int m = 0; m < 4; ++m) _Pragma("unroll") for (int k = 0; k < 2; ++k) dst[m][k] = *(const PG8_LAS bf16x8*)(lds + PG8_SA(b, h) + aoff + m * 2048 + k * 1024); } while (0)
#define PG8_LDB(dst, b, h) do { _Pragma("unroll") for (int n = 0; n < 2; ++n) _Pragma("unroll") for (int k = 0; k < 2; ++k) dst[n][k] = *(const PG8_LAS bf16x8*)(lds + PG8_SB(b, h) + boff + n * 2048 + k * 1024); } while (0)
#define PG8_MMA(ai, bj, At, Bt) do { __builtin_amdgcn_s_setprio(1); _Pragma("unroll") for (int m = 0; m < 4; ++m) _Pragma("unroll") for (int n = 0; n < 2; ++n) _Pragma("unroll") for (int k = 0; k < 2; ++k) \
        acc[ai][bj][m][n] = __builtin_amdgcn_mfma_f32_16x16x32_bf16(Bt[n][k], At[m][k], acc[ai][bj][m][n], 0, 0, 0); __builtin_amdgcn_s_setprio(0); } while (0)
#define PG8_WAIT_V(n) asm volatile("s_waitcnt vmcnt(" #n ")" ::: "memory")
#define PG8_WAIT_L(n) asm volatile("s_waitcnt lgkmcnt(" #n ")" ::: "memory")
#define PG8_BAR __builtin_amdgcn_s_barrier()
#define PG8_SCHED __builtin_amdgcn_sched_barrier(0)
    Unit cur, nxt; int ui = 0;
    if (!S.next(0, cur)) return;
    f32x4 acc[2][2][4][2];
#pragma unroll
    for (int a = 0; a < 2; ++a)
#pragma unroll
        for (int b = 0; b < 2; ++b)
#pragma unroll
            for (int m = 0; m < 4; ++m)
#pragma unroll
                for (int n = 0; n < 2; ++n) acc[a][b][m][n] = (f32x4){0.f, 0.f, 0.f, 0.f};
    bf16x8 At[4][2], B0[2][2], B1[2][2];
    const char* cA = (const char*)g.A + (size_t)cur.pm * tstep; const char* cB = (const char*)g.Bt + (size_t)cur.pn * tstep;
    S.a_ready(cur);
    if constexpr (SP2) {
        PG8_STAGE(PG8_SB(0, 0), cB, voffB); PG8_STAGE(PG8_SB(0, 1), cB + hstep, voffB); PG8_STAGE(PG8_SA(0, 0), cA, voffA); PG8_STAGE(PG8_SA(0, 1), cA + hstep, voffA);
        if (wr == 1) PG8_BAR;
        PG8_WAIT_V(2); PG8_BAR;
        PG8_STAGE(PG8_SB(1, 0), cB + kstep, voffB); PG8_STAGE(PG8_SA(1, 0), cA + kstep, voffA); PG8_STAGE(PG8_SB(1, 1), cB + hstep + kstep, voffB);
        PG8_WAIT_V(6); PG8_BAR;
    } else {
        PG8_STAGE(PG8_SB(0, 0), cB, voffB); PG8_STAGE(PG8_SA(0, 0), cA, voffA); PG8_STAGE(PG8_SB(0, 1), cB + hstep, voffB); PG8_STAGE(PG8_SA(0, 1), cA + hstep, voffA);
        if (wr == 1) PG8_BAR;
        PG8_WAIT_V(4); PG8_BAR;
        PG8_STAGE(PG8_SB(1, 0), cB + kstep, voffB); PG8_STAGE(PG8_SA(1, 0), cA + kstep, voffA); PG8_STAGE(PG8_SB(1, 1), cB + hstep + kstep, voffB);
        PG8_WAIT_V(6); PG8_BAR;
    }
    for (;;) {
        const bool has_next = S.next(ui + 1, nxt);
        const char* nA = has_next ? (const char*)g.A + (size_t)nxt.pm * tstep : cA; const char* nB = has_next ? (const char*)g.Bt + (size_t)nxt.pn * tstep : cB;
        for (int t = 0; t < nt; t += 2) {
            const bool last = (t == nt - 2);
            const char* a1 = cA + (size_t)(t + 1) * kstep;
            const char* a2 = last ? nA : cA + (size_t)(t + 2) * kstep; const char* b2 = last ? nB : cB + (size_t)(t + 2) * kstep;
            const char* a3 = a2 + kstep; const char* b3 = b2 + kstep;
            if (last && has_next) S.a_ready(nxt);
            if constexpr (SP2) {
            PG8_LDB(B0, 0, 0); PG8_LDB(B1, 0, 1); PG8_SCHED; PG8_LDA(At, 0, 0); PG8_STAGE(PG8_SA(1, 1), a1 + hstep, voffA);
            PG8_WAIT_V(8); PG8_WAIT_L(0); PG8_BAR; PG8_MMA(0, 0, At, B0); PG8_MMA(0, 1, At, B1); PG8_BAR; PG8_SCHED;
            PG8_LDA(At, 0, 1); PG8_STAGE(PG8_SB(0, 0), b2, voffB); PG8_STAGE(PG8_SB(0, 1), b2 + hstep, voffB); PG8_STAGE(PG8_SA(0, 0), a2, voffA);
            PG8_WAIT_V(8); PG8_WAIT_L(0); PG8_BAR; PG8_MMA(1, 0, At, B0); PG8_MMA(1, 1, At, B1); PG8_BAR; PG8_SCHED;
            PG8_LDB(B0, 1, 0); PG8_LDB(B1, 1, 1); PG8_SCHED; PG8_LDA(At, 1, 0); PG8_STAGE(PG8_SA(0, 1), a2 + hstep, voffA);
            PG8_WAIT_V(8); PG8_WAIT_L(0); PG8_BAR; PG8_MMA(0, 0, At, B0); PG8_MMA(0, 1, At, B1); PG8_BAR; PG8_SCHED;
            PG8_LDA(At, 1, 1); PG8_STAGE(PG8_SB(1, 0), b3, voffB); PG8_STAGE(PG8_SB(1, 1), b3 + hstep, voffB); PG8_STAGE(PG8_SA(1, 0), a3, voffA);
            PG8_WAIT_V(8); PG8_WAIT_L(0); PG8_BAR; PG8_MMA(1, 0, At, B0); PG8_MMA(1, 1, At, B1); PG8_BAR; PG8_SCHED;
            } else {
            PG8_LDB(B0, 0, 0); PG8_SCHED; PG8_LDA(At, 0, 0); PG8_STAGE(PG8_SA(1, 1), a1 + hstep, voffA);
            PG8_WAIT_L(8); PG8_BAR; PG8_WAIT_L(0); PG8_MMA(0, 0, At, B0); PG8_BAR; PG8_SCHED;
            PG8_LDB(B1, 0, 1); PG8_STAGE(PG8_SB(0, 0), b2, voffB);
            PG8_BAR; PG8_WAIT_L(0); PG8_MMA(0, 1, At, B1); PG8_BAR;
            PG8_LDA(At, 0, 1); PG8_STAGE(PG8_SA(0, 0), a2, voffA);
            PG8_BAR; PG8_WAIT_L(0); PG8_MMA(1, 0, At, B0); PG8_BAR; PG8_SCHED;
            PG8_STAGE(PG8_SB(0, 1), b2 + hstep, voffB);
            PG8_WAIT_V(6); PG8_BAR; PG8_MMA(1, 1, At, B1); PG8_BAR;
            PG8_LDB(B0, 1, 0); PG8_SCHED; PG8_LDA(At, 1, 0); PG8_STAGE(PG8_SA(0, 1), a2 + hstep, voffA);
            PG8_WAIT_L(8); PG8_BAR; PG8_WAIT_L(0); PG8_MMA(0, 0, At, B0); PG8_BAR; PG8_SCHED;
            PG8_LDB(B1, 1, 1); PG8_STAGE(PG8_SB(1, 0), b3, voffB);
            PG8_BAR; PG8_WAIT_L(0); PG8_MMA(0, 1, At, B1); PG8_BAR;
            PG8_LDA(At, 1, 1); PG8_STAGE(PG8_SA(1, 0), a3, voffA);
            PG8_BAR; PG8_WAIT_L(0); PG8_MMA(1, 0, At, B0); PG8_BAR; PG8_SCHED;
            PG8_STAGE(PG8_SB(1, 1), b3 + hstep, voffB);
            PG8_WAIT_V(6); PG8_BAR; PG8_MMA(1, 1, At, B1); PG8_BAR;
            }
        }
        if constexpr (ALIGN_EPI) { if (wr == 0) PG8_BAR; }
        if constexpr (!Epi::AFTER_DRAIN) { E(acc, cur, wr, wc, fr, fq); S.done(cur); }
        if (!has_next) break;
#pragma unroll
        for (int a = 0; a < 2; ++a)
#pragma unroll
            for (int b = 0; b < 2; ++b)
#pragma unroll
                for (int m = 0; m < 4; ++m)
#pragma unroll
                    for (int n = 0; n < 2; ++n) acc[a][b][m][n] = (f32x4){0.f, 0.f, 0.f, 0.f};
        cur = nxt; cA = nA; cB = nB; ++ui;
        if constexpr (ALIGN_EPI) { if (wr == 1) PG8_BAR; }
    }
    PG8_WAIT_V(0);
    if constexpr (!ALIGN_EPI) { if (wr == 0) PG8_BAR; }
    PG8_BAR;
    if constexpr (Epi::AFTER_DRAIN) { E.fused(acc, cur, wr, wc, fr, fq, lds, wid, lane); S.done(cur); }
#undef PG8_SA
#undef PG8_SB
#undef PG8_STAGE
#undef PG8_LDA
#undef PG8_LDB
#undef PG8_MMA
#undef PG8_WAIT_V
#undef PG8_WAIT_L
#undef PG8_BAR
#undef PG8_SCHED
}
}

constexpr int DM = 1024, DFF = 2816, DA = 512, NIN = 5632;
constexpr int TP = 16384, TS = 1024, T = TP + TS;
constexpr int NSEQ_P = 32, NSEQ_S = 512;
constexpr float EPS = 1e-6f;
constexpr int NWAVES = 8;

constexpr size_t OUT_Y = 0, OUT_SHP = (size_t)T * DM, OUT_SCP = OUT_SHP + 524288, OUT_SHS = OUT_SCP + 8192, OUT_SCS = OUT_SHS + 8388608, OUT_END = OUT_SCS + 131072;

constexpr size_t MiB = 1u << 20;
constexpr size_t WS_CTL = 0, CTL_ZERO_BYTES = 1 * MiB;
constexpr size_t WS_WIN = 1 * MiB, WS_WA = 12 * MiB, WS_WB = 13 * MiB, WS_WO = 14 * MiB;
constexpr size_t WS_W13 = 16 * MiB, WS_W2 = 27 * MiB;
constexpr size_t WS_XN = 32 * MiB + 512 * 1024;
constexpr size_t WS_ARENA = WS_XN + 34 * MiB;
constexpr size_t UNITB = (size_t)T * 512 * 2;
constexpr size_t WS_H = WS_ARENA;
constexpr size_t WS_SGA = WS_ARENA, WS_SGB = WS_ARENA + 2 * UNITB, WS_OG = WS_ARENA + 4 * UNITB, WS_BG = WS_ARENA + 5 * UNITB, WS_U = WS_ARENA + 6 * UNITB;
constexpr size_t WS_Q = WS_ARENA + 7 * UNITB, WS_V = WS_ARENA + 8 * UNITB, WS_LOGF = WS_ARENA + 9 * UNITB;
constexpr size_t WS_ZA = WS_Q, WS_ZB = WS_V, WS_MG = WS_LOGF;
constexpr size_t WS_PARTP = WS_ARENA + 11 * UNITB;
constexpr size_t WS_PARTS = WS_PARTP + (size_t)TP * 16;
constexpr size_t WS_END = WS_PARTS + (size_t)TS * 64;
static_assert(WS_END <= 256 * MiB, "ws map");
static_assert((size_t)T * DFF * 2 <= 6 * UNITB, "H fits");
constexpr int CW_BAR = 4096;

constexpr int RING_BYTES = 131072, LDSCTL_OFF = RING_BYTES, MISC_OFF = LDSCTL_OFF + 320, ROWSUM_OFF = RING_BYTES + 2048, PMT_OFF = RING_BYTES + 3072, RSL_OFF = RING_BYTES + 4096, RSL_SLOTS = 6, LDS_BYTES = 147456;

#define GAS __attribute__((address_space(1)))
#define LAS __attribute__((address_space(3)))
typedef unsigned short bf16;
typedef unsigned v4u __attribute__((ext_vector_type(4)));
typedef unsigned v2u __attribute__((ext_vector_type(2)));
typedef float f32x4 __attribute__((ext_vector_type(4)));
typedef short bf16x8 __attribute__((ext_vector_type(8)));
typedef GAS unsigned gu32;
#define NTL(p) (*(p))
#define LDS_WAIT() asm volatile("s_waitcnt lgkmcnt(0)" ::: "memory")
#define VM_WAIT() asm volatile("s_waitcnt vmcnt(0)" ::: "memory")
#define LDSBAR() do { asm volatile("s_waitcnt lgkmcnt(0)" ::: "memory"); __builtin_amdgcn_s_barrier(); asm volatile("" ::: "memory"); } while (0)
__device__ __forceinline__ unsigned f2bf(float f) { unsigned u = __builtin_bit_cast(unsigned, f); return (u + 0x7fffu + ((u >> 16) & 1u)) >> 16; }
typedef float f32x2_t_ __attribute__((ext_vector_type(2)));
typedef __bf16 bf16x2_t_ __attribute__((ext_vector_type(2)));
__device__ __forceinline__ unsigned pk2(float lo, float hi) { const f32x2_t_ v = {lo, hi}; return __builtin_bit_cast(unsigned, __builtin_convertvector(v, bf16x2_t_)); }
__device__ __forceinline__ float bf2f(unsigned short h) { return __builtin_bit_cast(float, (unsigned)h << 16); }
__device__ __forceinline__ float bflo(unsigned w) { return __builtin_bit_cast(float, w << 16); }
__device__ __forceinline__ float bfhi(unsigned w) { return __builtin_bit_cast(float, w & 0xffff0000u); }
__device__ __forceinline__ float sigmoidf_(float x) { return __builtin_amdgcn_rcpf(1.0f + __expf(-x)); }
__device__ __forceinline__ float siluf_(float x) { return x * sigmoidf_(x); }

#define XB_TMO      128
#define XB_XCNT(j)  (256  + 64 * (j))
#define XB_XSUB(j)  (1280 + 64 * (j))
#define XB_XGEN(j)  (2304 + 64 * (j))
#define XB_TOP      3328
#define XB_TOPGEN   3392
#define XCD_BAR_WORDS 3456
#define XB_SPIN_CAP (1u << 18)

__device__ __forceinline__ unsigned xb_ld(unsigned* p)              { return __hip_atomic_load(p, __ATOMIC_RELAXED, __HIP_MEMORY_SCOPE_AGENT); }
__device__ __forceinline__ unsigned xb_add(unsigned* p, unsigned v) { return __hip_atomic_fetch_add(p, v, __ATOMIC_RELAXED, __HIP_MEMORY_SCOPE_AGENT); }
__device__ __forceinline__ unsigned xb_xcc_id() { return (unsigned)__builtin_amdgcn_s_getreg((3 << 11) | 20) & 0xFu; }
#define XB_SPIN(cond, bar) do { unsigned _sp = 0; while (cond) { __builtin_amdgcn_s_sleep(1); \
    if ((++_sp & 255u) == 0u) { if (xb_ld(&(bar)[XB_TMO])) break; if (_sp > XB_SPIN_CAP) { atomicAdd(&(bar)[XB_TMO], 1u); break; } } } } while (0)

struct XcdBarrier {
    unsigned* bar; unsigned x;
    volatile LAS unsigned* st;
};

__device__ __forceinline__ XcdBarrier xcd_barrier_post(unsigned* bar, volatile LAS unsigned* st) {
    XcdBarrier b; b.bar = bar; b.x = xb_xcc_id(); b.st = st;
    if (threadIdx.x == 0) (void)xb_add(&bar[XB_XCNT(b.x)], 1u);
    return b;
}
__device__ __forceinline__ void xcd_barrier_complete(unsigned* bar, unsigned x, unsigned& nloc, unsigned& nx) {
    const unsigned G = gridDim.x * gridDim.y * gridDim.z;
    unsigned sum, cnt, mine, sp = 0u;
    for (;;) {
        sum = 0u; cnt = 0u; mine = 0u;
#pragma unroll
        for (unsigned j = 0; j < 16; ++j) { const unsigned c = xb_ld(&bar[XB_XCNT(j)]); sum += c; cnt += (c > 0u) ? 1u : 0u; mine = (j == x) ? c : mine; }
        if (sum == G) break;
        __builtin_amdgcn_s_sleep(1);
        if ((++sp & 255u) == 0u) { if (xb_ld(&bar[XB_TMO])) break; if (sp > XB_SPIN_CAP) { atomicAdd(&bar[XB_TMO], 1u); break; } }
    }
    nloc = mine > 0u ? mine : 1u; nx = cnt > 0u ? cnt : 1u;
}

__device__ __forceinline__ void xcd_barrier(const XcdBarrier& b) {
    asm volatile("s_waitcnt vmcnt(0)" ::: "memory");
    __syncthreads();
    if (threadIdx.x == 0) {
        unsigned* bar = b.bar;
        __builtin_amdgcn_s_waitcnt(0);
        unsigned nloc = b.st[0], nx = b.st[1];
        if (nloc == 0u) { xcd_barrier_complete(bar, b.x, nloc, nx); b.st[0] = nloc; b.st[1] = nx; }
        const unsigned old = xb_add(&bar[XB_XSUB(b.x)], 1u);
        const unsigned gen = old / nloc;
        if (old + 1u == (gen + 1u) * nloc) {
            __builtin_amdgcn_fence(__ATOMIC_RELEASE, "agent");
            asm volatile("s_waitcnt vmcnt(0)" ::: "memory");
            const unsigned og = xb_add(&bar[XB_TOP], 1u);
            const unsigned tg = og / nx;
            if (og + 1u == (tg + 1u) * nx) xb_add(&bar[XB_TOPGEN], 1u);
            else XB_SPIN(xb_ld(&bar[XB_TOPGEN]) == tg, bar);
            __builtin_amdgcn_fence(__ATOMIC_ACQUIRE, "agent");
            xb_add(&bar[XB_XGEN(b.x)], 1u);
            asm volatile("s_waitcnt vmcnt(0)" ::: "memory");
        } else {
            XB_SPIN(xb_ld(&bar[XB_XGEN(b.x)]) == gen, bar);
            __builtin_amdgcn_fence(__ATOMIC_ACQUIRE, "agent");
            asm volatile("s_waitcnt vmcnt(0)" ::: "memory");
        }
    }
    __syncthreads();
}


#if defined(PROBE_E2) || defined(PROBE_E3) || defined(PROBE_E4) || defined(PROBE_E5)
__device__ __forceinline__ void xcd_barrier_probe(const XcdBarrier& b) {
    asm volatile("s_waitcnt vmcnt(0)" ::: "memory");
    __syncthreads();
    if (threadIdx.x == 0) {
        unsigned* bar = b.bar;
        unsigned nloc = b.st[0], nx = b.st[1];
        const unsigned old = xb_add(&bar[XB_XSUB(b.x)], 1u);
        const unsigned gen = old / nloc;
        if (old + 1u == (gen + 1u) * nloc) {
#if !defined(PROBE_E3) && !defined(PROBE_E4)
            __builtin_amdgcn_fence(__ATOMIC_RELEASE, "agent");
#endif
            asm volatile("s_waitcnt vmcnt(0)" ::: "memory");
            const unsigned og = xb_add(&bar[XB_TOP], 1u);
            const unsigned tg = og / nx;
            if (og + 1u == (tg + 1u) * nx) xb_add(&bar[XB_TOPGEN], 1u);
            else XB_SPIN(xb_ld(&bar[XB_TOPGEN]) == tg, bar);
#if !defined(PROBE_E2) && !defined(PROBE_E4)
            __builtin_amdgcn_fence(__ATOMIC_ACQUIRE, "agent");
#endif
            xb_add(&bar[XB_XGEN(b.x)], 1u);
            asm volatile("s_waitcnt vmcnt(0)" ::: "memory");
        } else {
            XB_SPIN(xb_ld(&bar[XB_XGEN(b.x)]) == gen, bar);
#if !defined(PROBE_E2) && !defined(PROBE_E4) && !defined(PROBE_E5)
            __builtin_amdgcn_fence(__ATOMIC_ACQUIRE, "agent");
#endif
            asm volatile("s_waitcnt vmcnt(0)" ::: "memory");
        }
    }
    __syncthreads();
}
#endif

namespace pg8 {
static_assert(RSL_OFF + RSL_SLOTS * 1024 <= LDS_BYTES, "rstd slots inside the LDS allocation");
__device__ __forceinline__ float row_rstd(const float* PP, const float* PS, int row) {
    float ss;
    if (row < TP) { const f32x4 a = NTL((const f32x4*)(PP + (size_t)row * 4)); ss = (a[0] + a[1]) + (a[2] + a[3]); }
    else { const f32x4* p = (const f32x4*)(PS + (size_t)(row - TP) * 16); const f32x4 a = (NTL(p) + NTL(p + 1)) + (NTL(p + 2) + NTL(p + 3)); ss = (a[0] + a[1]) + (a[2] + a[3]); }
    return 1.0f / sqrtf(ss * (1.0f / DM) + EPS);
}
__device__ __forceinline__ int rstd_slot(PG8_LAS unsigned char* ldsb, int pm) {
    const PG8_LAS int* PMT = (const PG8_LAS int*)(ldsb + PMT_OFF); int slot = -1;
#pragma unroll
    for (int i = 0; i < RSL_SLOTS; ++i) if (PMT[i] == pm) slot = i;
    return slot;
}
struct EpiSwiglu {
    static constexpr bool PERM = false, AFTER_DRAIN = false;
    bf16_t* H; int ldh; const float* PP; const float* PS; PG8_LAS unsigned char* ldsb;
    __device__ __forceinline__ void operator()(const f32x4 (&acc)[2][2][4][2], const Unit& u, int wr, int wc, int fr, int fq) const {
        const int row0 = u.pm * BM + wr * 64 + fr, hid0 = u.pn * 128 + wc * 16 + 4 * fq;
        float rs[2][4];
#pragma unroll
        for (int ai = 0; ai < 2; ++ai)
#pragma unroll
            for (int m = 0; m < 4; ++m) rs[ai][m] = 1.0f;
        if (PP) { const int slot = rstd_slot(ldsb, u.pm); const PG8_LAS float* RSL = (const PG8_LAS float*)(ldsb + RSL_OFF) + (slot < 0 ? 0 : slot) * 256 + wr * 64 + fr;
#pragma unroll
            for (int ai = 0; ai < 2; ++ai)
#pragma unroll
                for (int m = 0; m < 4; ++m) rs[ai][m] = slot >= 0 ? RSL[ai * HALF + m * 16] : row_rstd(PP, PS, row0 + ai * HALF + m * 16); }
#pragma unroll
        for (int ai = 0; ai < 2; ++ai)
#pragma unroll
            for (int m = 0; m < 4; ++m) { bf16_t* rowp = H + (size_t)(row0 + ai * HALF + m * 16) * ldh + hid0;
#pragma unroll
                for (int bj = 0; bj < 2; ++bj) { const f32x4 a = acc[ai][bj][m][0] * rs[ai][m], b = acc[ai][bj][m][1] * rs[ai][m];
                    v2u w; w.x = pk2(siluf_(a[0]) * b[0], siluf_(a[1]) * b[1]); w.y = pk2(siluf_(a[2]) * b[2], siluf_(a[3]) * b[3]);
                    *(v2u*)(rowp + bj * 64) = w; } }
    }
};
template <bool HALF_ALPHA> struct EpiRes {
    static constexpr bool PERM = false, AFTER_DRAIN = false;
    static constexpr float alpha = HALF_ALPHA ? 0.5f : 1.0f;
    const float* srcP; const float* srcS; float* out; bf16_t* XNo; float* PP; float* PS; PG8_LAS unsigned char* ldsb; const float* gain;
    __device__ __forceinline__ bool has_norm() const { return XNo != nullptr; }
    __device__ __forceinline__ float store4(int row, int col, f32x4 a) const {
        const float* sb = (row < TP) ? srcP : srcS - (size_t)TP * DM; const size_t o = (size_t)row * DM + col;
        const f32x4 s = NTL((const f32x4*)(sb + o)); const f32x4 v = s + a * alpha; *(f32x4*)(out + o) = v;
        if (XNo) { const f32x4 gg = *(const f32x4*)(gain + col); v2u w; w.x = pk2(v[0] * gg[0], v[1] * gg[1]); w.y = pk2(v[2] * gg[2], v[3] * gg[3]); *(v2u*)(XNo + o) = w; return (v[0] * v[0] + v[1] * v[1]) + (v[2] * v[2] + v[3] * v[3]); }
        return 0.f;
    }
    __device__ __forceinline__ void row_store_s(int row, int slot, float ss) const { PS[(size_t)(row - TP) * 16 + slot] = ss; }
    struct Pre { f32x4 s; };
    __device__ __forceinline__ Pre pre4(int row, int col) const { const float* sb = (row < TP) ? srcP : srcS - (size_t)TP * DM; Pre p; p.s = NTL((const f32x4*)(sb + (size_t)row * DM + col)); return p; }
    __device__ __forceinline__ float store4pg(int row, int col, f32x4 a, const Pre& p, f32x4 gg) const {
        const size_t o = (size_t)row * DM + col; const f32x4 v = p.s + a * alpha; *(f32x4*)(out + o) = v;
        if (XNo) { v2u w; w.x = pk2(v[0] * gg[0], v[1] * gg[1]); w.y = pk2(v[2] * gg[2], v[3] * gg[3]); *(v2u*)(XNo + o) = w; return (v[0] * v[0] + v[1] * v[1]) + (v[2] * v[2] + v[3] * v[3]); }
        return 0.f;
    }
    __device__ __forceinline__ float store4p(int row, int col, f32x4 a, const Pre& p) const {
        const size_t o = (size_t)row * DM + col; const f32x4 v = p.s + a * alpha; *(f32x4*)(out + o) = v;
        if (XNo) { const f32x4 gg = *(const f32x4*)(gain + col); v2u w; w.x = pk2(v[0] * gg[0], v[1] * gg[1]); w.y = pk2(v[2] * gg[2], v[3] * gg[3]); *(v2u*)(XNo + o) = w; return (v[0] * v[0] + v[1] * v[1]) + (v[2] * v[2] + v[3] * v[3]); }
        return 0.f;
    }
    __device__ __forceinline__ void operator()(const f32x4 (&acc)[2][2][4][2], const Unit& u, int wr, int wc, int fr, int fq) const {
        const int row0 = u.pm * BM + wr * 64 + fr, col0 = u.pn * BM + wc * 32 + 4 * fq;
        PG8_LAS float* ROWSUM = (PG8_LAS float*)(ldsb + ROWSUM_OFF);
        const bool norm = has_norm();
        if (norm) { if (threadIdx.x < 256) ROWSUM[threadIdx.x] = 0.f; asm volatile("s_waitcnt lgkmcnt(0)" ::: "memory"); __builtin_amdgcn_s_barrier(); asm volatile("" ::: "memory"); }
        f32x4 gg[2][2];
#pragma unroll
        for (int bj = 0; bj < 2; ++bj)
#pragma unroll
            for (int n = 0; n < 2; ++n) gg[bj][n] = norm ? *(const f32x4*)(gain + col0 + bj * HALF + n * 16) : (f32x4){0.f, 0.f, 0.f, 0.f};
#pragma unroll
        for (int am = 0; am < 4; ++am) {
            const int ai = am >> 1, mb = (am & 1) * 2;
            Pre pv[2][2][2];
#pragma unroll
            for (int mm = 0; mm < 2; ++mm)
#pragma unroll
                for (int bj = 0; bj < 2; ++bj)
#pragma unroll
                    for (int n = 0; n < 2; ++n) pv[mm][bj][n] = pre4(row0 + ai * HALF + (mb + mm) * 16, col0 + bj * HALF + n * 16);
#pragma unroll
            for (int mm = 0; mm < 2; ++mm) { const int m = mb + mm; float ss = 0.f;
#pragma unroll
                for (int bj = 0; bj < 2; ++bj)
#pragma unroll
                    for (int n = 0; n < 2; ++n) ss += store4pg(row0 + ai * HALF + m * 16, col0 + bj * HALF + n * 16, acc[ai][bj][m][n], pv[mm][bj][n], gg[bj][n]);
                if (norm) { ss += __shfl_xor(ss, 16); ss += __shfl_xor(ss, 32); if (fq == 0) (void)__hip_atomic_fetch_add(ROWSUM + ai * HALF + wr * 64 + m * 16 + fr, ss, __ATOMIC_RELAXED, __HIP_MEMORY_SCOPE_WORKGROUP); } }
        }
        if (norm) { asm volatile("s_waitcnt lgkmcnt(0)" ::: "memory"); __builtin_amdgcn_s_barrier(); asm volatile("" ::: "memory");
            if (threadIdx.x < 256) PP[(size_t)(u.pm * BM + threadIdx.x) * 4 + u.pn] = ROWSUM[threadIdx.x]; }
    }
};
template <int MODE> struct EpiGate {
    static constexpr bool PERM = false, AFTER_DRAIN = false;
    const bf16_t* SG; bf16_t* MG;
    __device__ __forceinline__ bool has_norm() const { return false; }
    __device__ __forceinline__ void row_store_s(int, int, float) const {}
    struct Pre { v2u g, m; };
    __device__ __forceinline__ Pre pre4(int row, int col) const { const size_t o = (size_t)row * DM + col; Pre p; p.g = NTL((const v2u*)(SG + o)); p.m = (v2u){0u, 0u}; if (MODE == 1) p.m = NTL((const v2u*)(MG + o)); return p; }
    __device__ __forceinline__ float store4p(int row, int col, f32x4 a, const Pre& p) const {
        const size_t o = (size_t)row * DM + col;
        float r0 = bflo(p.g.x) * a[0], r1 = bfhi(p.g.x) * a[1], r2 = bflo(p.g.y) * a[2], r3 = bfhi(p.g.y) * a[3];
        if (MODE == 1) { r0 += bflo(p.m.x); r1 += bfhi(p.m.x); r2 += bflo(p.m.y); r3 += bfhi(p.m.y); }
        v2u w; w.x = pk2(r0, r1); w.y = pk2(r2, r3); *(v2u*)(MG + o) = w; return 0.f;
    }
    __device__ __forceinline__ float store4(int row, int col, f32x4 a) const {
        const size_t o = (size_t)row * DM + col; const v2u g = NTL((const v2u*)(SG + o));
        float r0 = bflo(g.x) * a[0], r1 = bfhi(g.x) * a[1], r2 = bflo(g.y) * a[2], r3 = bfhi(g.y) * a[3];
        if (MODE == 1) { const v2u p = NTL((const v2u*)(MG + o)); r0 += bflo(p.x); r1 += bfhi(p.x); r2 += bflo(p.y); r3 += bfhi(p.y); }
        v2u w; w.x = pk2(r0, r1); w.y = pk2(r2, r3); *(v2u*)(MG + o) = w; return 0.f;
    }
    __device__ __forceinline__ void operator()(const f32x4 (&acc)[2][2][4][2], const Unit& u, int wr, int wc, int fr, int fq) const {
        const int row0 = u.pm * BM + wr * 64 + fr, col0 = u.pn * BM + wc * 32 + 4 * fq;
#pragma unroll
        for (int am = 0; am < 4; ++am) {
            const int ai = am >> 1, mb = (am & 1) * 2;
            Pre pv[2][2][2];
#pragma unroll
            for (int mm = 0; mm < 2; ++mm)
#pragma unroll
                for (int bj = 0; bj < 2; ++bj)
#pragma unroll
                    for (int n = 0; n < 2; ++n) pv[mm][bj][n] = pre4(row0 + ai * HALF + (mb + mm) * 16, col0 + bj * HALF + n * 16);
#pragma unroll
            for (int mm = 0; mm < 2; ++mm)
#pragma unroll
                for (int bj = 0; bj < 2; ++bj)
#pragma unroll
                    for (int n = 0; n < 2; ++n) (void)store4p(row0 + ai * HALF + (mb + mm) * 16, col0 + bj * HALF + n * 16, acc[ai][bj][mb + mm][n], pv[mm][bj][n]);
        }
    }
};
struct EpiMix {
    static constexpr bool PERM = false, AFTER_DRAIN = false;
    bf16_t *Q, *V, *OG, *BG, *U, *SGA, *SGB; float* LOGF; const float* lbl; const float* PP; const float* PS; PG8_LAS unsigned char* ldsb;
    __device__ __forceinline__ void operator()(const f32x4 (&acc_)[2][2][4][2], const Unit& u, int wr, int wc, int fr, int fq) const {
        const int pn = u.pn, row0 = u.pm * BM + wr * 64 + fr;
        f32x4 acc[2][2][4][2];
        { float rs[2][4]; const int slot_ = rstd_slot(ldsb, u.pm); const PG8_LAS float* RSL_ = (const PG8_LAS float*)(ldsb + RSL_OFF) + (slot_ < 0 ? 0 : slot_) * 256 + wr * 64 + fr;
#pragma unroll
          for (int ai = 0; ai < 2; ++ai)
#pragma unroll
              for (int m = 0; m < 4; ++m) { rs[ai][m] = slot_ >= 0 ? RSL_[ai * HALF + m * 16] : row_rstd(PP, PS, row0 + ai * HALF + m * 16); }
#pragma unroll
          for (int ai = 0; ai < 2; ++ai)
#pragma unroll
              for (int m = 0; m < 4; ++m)
#pragma unroll
                  for (int bj = 0; bj < 2; ++bj)
#pragma unroll
                      for (int n = 0; n < 2; ++n) acc[ai][bj][m][n] = acc_[ai][bj][m][n] * rs[ai][m]; }
        if (pn >= 10 && pn < 14) {
            const int ch0 = (pn - 10) * 128 + wc * 16 + 4 * fq;
#pragma unroll
            for (int ai = 0; ai < 2; ++ai)
#pragma unroll
                for (int m = 0; m < 4; ++m) { bf16_t* rowp = U + (size_t)(row0 + ai * HALF + m * 16) * DA + ch0;
#pragma unroll
                    for (int bj = 0; bj < 2; ++bj) { const f32x4 a = acc[ai][bj][m][0], b = acc[ai][bj][m][1];
                        v2u w; w.x = pk2(a[0] * b[0], a[1] * b[1]); w.y = pk2(a[2] * b[2], a[3] * b[3]); *(v2u*)(rowp + bj * 64) = w; } }
            return;
        }
        const int colt = wc * 32 + 4 * fq;
        if (pn == 2 || pn == 3) {
            const int c0 = (pn - 2) * 256 + colt;
#pragma unroll
            for (int bj = 0; bj < 2; ++bj)
#pragma unroll
                for (int n = 0; n < 2; ++n) { const int c = c0 + bj * HALF + n * 16;
                    const f32x4 l0 = *(const f32x4*)(lbl + c), l1 = *(const f32x4*)(lbl + 512 + c); f32x4 lb;
#pragma unroll
                    for (int i = 0; i < 4; ++i) lb[i] = sigmoidf_(l0[i] - l1[i]);
#pragma unroll
                    for (int ai = 0; ai < 2; ++ai)
#pragma unroll
                        for (int m = 0; m < 4; ++m) { const f32x4 z = acc[ai][bj][m][n]; f32x4 o;
#pragma unroll
                            for (int i = 0; i < 4; ++i) o[i] = __logf(lb[i] + (1.0f - lb[i]) * sigmoidf_(z[i]));
                            *(f32x4*)(LOGF + (size_t)(row0 + ai * HALF + m * 16) * DA + c) = o; } }
            return;
        }
        bf16_t* base; int ld, c0, act;
        if (pn < 2) { base = Q; ld = DA; c0 = pn * 256; act = 0; }
        else if (pn < 6) { base = V; ld = DA; c0 = (pn - 4) * 256; act = 0; }
        else if (pn < 8) { base = OG; ld = DA; c0 = (pn - 6) * 256; act = 1; }
        else if (pn < 10) { base = BG; ld = DA; c0 = (pn - 8) * 256; act = 0; }
        else if (pn < 18) { base = SGA; ld = DM; c0 = (pn - 14) * 256; act = 2; }
        else { base = SGB; ld = DM; c0 = (pn - 18) * 256; act = 2; }
        c0 += colt;
#pragma unroll
        for (int ai = 0; ai < 2; ++ai)
#pragma unroll
            for (int m = 0; m < 4; ++m) { bf16_t* rowp = base + (size_t)(row0 + ai * HALF + m * 16) * ld + c0;
#pragma unroll
                for (int bj = 0; bj < 2; ++bj)
#pragma unroll
                    for (int n = 0; n < 2; ++n) { f32x4 a = acc[ai][bj][m][n];
                        if (act == 1) { a[0] = siluf_(a[0]); a[1] = siluf_(a[1]); a[2] = siluf_(a[2]); a[3] = siluf_(a[3]); }
                        else if (act == 2) { a[0] = sigmoidf_(a[0]); a[1] = sigmoidf_(a[1]); a[2] = sigmoidf_(a[2]); a[3] = sigmoidf_(a[3]); }
                        v2u w; w.x = pk2(a[0], a[1]); w.y = pk2(a[2], a[3]); *(v2u*)(rowp + bj * HALF + n * 16) = w; } }
    }
};
}

struct Frame {
    LAS unsigned char* lds;
    volatile LAS unsigned* MISC;
    gu32* ctl;
    int tid, lane, wave, vcu, G;
};
struct Args { const float* in[21]; float* out; unsigned char* ws; unsigned mask; unsigned pad; };
typedef const __attribute__((address_space(4))) Args* KArgs;
__device__ __forceinline__ const float* kin(int k) { KArgs p = (KArgs)__builtin_amdgcn_kernarg_segment_ptr(); asm volatile("" : "+s"(p)); return p->in[k]; }

__device__ __forceinline__ float wave_sum(float v) {
#pragma unroll
    for (int o = 1; o < 64; o <<= 1) v += __shfl_xor(v, o);
    return v;
}
__device__ __forceinline__ void transpose_item(const float* W, const float* g, int ldw, int K, int ncols, bf16* WT, int mode, int roff, LAS float* scr, int item, int lane) {
    const int nblk = ncols / 32, kb = item / nblk, nb = item % nblk, k0 = 64 * kb, n0 = 32 * nb;
    const float g0 = g ? g[k0 + lane] : 1.0f;
#pragma unroll 8
    for (int i = 0; i < 32; ++i) { const int kk = 2 * i + (lane >> 5); scr[kk * 33 + (lane & 31)] = W[(size_t)(k0 + kk) * ldw + n0 + (lane & 31)] * __shfl(g0, kk); }
    LDS_WAIT(); asm volatile("" ::: "memory");
    const int c = lane & 7;
#pragma unroll
    for (int j = 0; j < 4; ++j) { const int n = (lane >> 3) + 8 * j; const LAS float* s = scr + (8 * c) * 33 + n;
        v4u o; o.x = pk2(s[0 * 33], s[1 * 33]); o.y = pk2(s[2 * 33], s[3 * 33]); o.z = pk2(s[4 * 33], s[5 * 33]); o.w = pk2(s[6 * 33], s[7 * 33]);
        const int jc = n0 + n; const int drow = mode ? roff + ((jc >> 4) << 5) + (jc & 15) : roff + jc;
        *(GAS v4u*)(WT + (size_t)drow * K + k0 + 8 * c) = o; }
    LDS_WAIT(); asm volatile("" ::: "memory");
}
__device__ __forceinline__ void conv_mat(const float* W, const float* g, int ldw, int K, int ncols, bf16* WT, int mode, int roff, LAS float* scr, int lane, int gw, int NGW) {
    const int nitems = (K / 64) * (ncols / 32);
    for (int it = gw; it < nitems; it += NGW) transpose_item(W, g, ldw, K, ncols, WT, mode, roff, scr, it, lane);
}
__device__ __forceinline__ void conv_w13(const float* w1, const float* w3, const float* g, unsigned char* ws, LAS float* scr, int lane, int gw, int NGW) {
    bf16* W13 = (bf16*)(ws + WS_W13);
    conv_mat(w1, g, DFF, DM, DFF, W13, 1, 0, scr, lane, gw, NGW);
    conv_mat(w3, g, DFF, DM, DFF, W13, 1, 16, scr, lane, (gw + NGW / 2) % NGW, NGW);
}
__device__ __forceinline__ void conv_w2(const float* w2, unsigned char* ws, LAS float* scr, int lane, int gw, int NGW) {
    conv_mat(w2, nullptr, DM, DFF, DM, (bf16*)(ws + WS_W2), 0, 0, scr, lane, gw, NGW);
}
__device__ __forceinline__ void rms_row2_bf16(const float* xrowA, const float* xrowB, const float* g, bf16* orowA, bf16* orowB, int lane) {
    const int hl = lane & 31, hw = lane >> 5;
    const GAS f32x4* xr = (const GAS f32x4*)(hw ? xrowB : xrowA) + hl; const GAS f32x4* gr = (const GAS f32x4*)g + hl;
    f32x4 v[8]; float s = 0.f;
#pragma unroll
    for (int j = 0; j < 8; ++j) { v[j] = xr[32 * j]; s += (v[j].x * v[j].x + v[j].y * v[j].y) + (v[j].z * v[j].z + v[j].w * v[j].w); }
#pragma unroll
    for (int o = 1; o < 32; o <<= 1) s += __shfl_xor(s, o);
    const float rstd = 1.f / sqrtf(s * (1.f / DM) + EPS);
    GAS v2u* o8 = (GAS v2u*)(hw ? orowB : orowA) + hl;
#pragma unroll
    for (int j = 0; j < 8; ++j) { const f32x4 gg = gr[32 * j]; v2u w; w.x = pk2(v[j].x * rstd * gg.x, v[j].y * rstd * gg.y); w.y = pk2(v[j].z * rstd * gg.z, v[j].w * rstd * gg.w); o8[32 * j] = w; }
}
__device__ __forceinline__ void rms_row2_f32(float* xrow0, const float* g, int lane, bool second_valid) {
    const int hl = lane & 31, hw = lane >> 5;
    if (hw && !second_valid) return;
    GAS f32x4* xr = (GAS f32x4*)(xrow0 + (size_t)hw * DM) + hl; const GAS f32x4* gr = (const GAS f32x4*)g + hl;
    f32x4 v[8]; float s = 0.f;
#pragma unroll
    for (int j = 0; j < 8; ++j) { v[j] = NTL(xr + 32 * j); s += (v[j].x * v[j].x + v[j].y * v[j].y) + (v[j].z * v[j].z + v[j].w * v[j].w); }
#pragma unroll
    for (int o = 1; o < 32; o <<= 1) s += __shfl_xor(s, o);
    const float rstd = 1.f / sqrtf(s * (1.f / DM) + EPS);
#pragma unroll
    for (int j = 0; j < 8; ++j) { const f32x4 gg = gr[32 * j]; xr[32 * j] = v[j] * rstd * gg; }
}

__device__ __forceinline__ void hg_prep(const Frame& F, unsigned char* ws, unsigned char* sfr) {
    LAS unsigned char* L = F.lds;
    LAS float* LB = (LAS float*)L;
    LAS bf16* QD = (LAS bf16*)(L + 16896);
    LAS bf16* KD = (LAS bf16*)(L + 16896 + 8704);
    LAS bf16* KET = (LAS bf16*)(L + 16896 + 2 * 8704);
    LAS bf16* VT = (LAS bf16*)(L + 16896 + 2 * 8704 + 10240);
    LAS bf16* SC = (LAS bf16*)(L + 16896 + 2 * 8704 + 2 * 10240);
    const bf16* Qg = (const bf16*)(ws + WS_Q); const bf16* Vg = (const bf16*)(ws + WS_V); const float* LFg = (const float*)(ws + WS_LOGF);
    const int tid = F.tid, c = tid >> 4, kg = tid & 15, lane = F.lane, wave = F.wave;
    for (int u = F.vcu; u < 2048 + NSEQ_S; u += F.G) {
        int t0, nvalid, h; unsigned char *qf, *vf, *lf; int qp, lp;
        if (u < 2048) { const int b = u >> 8, n = u & 63; h = (u >> 6) & 3; t0 = b * 2048 + n * 32; nvalid = 32;
            const size_t e0 = (size_t)t0 * DA + h * 128; qf = ws + WS_Q + e0 * 2; vf = ws + WS_V + e0 * 2; lf = ws + WS_LOGF + e0 * 4; qp = 1024; lp = 2048; }
        else { const int su = u - 2048, b = su >> 2; h = su & 3; t0 = TP + b * 8; nvalid = 8;
            unsigned char* base = sfr + (size_t)su * 65536; qf = base; vf = base + 8192; lf = base + 16384; qp = 256; lp = 512; }
        f32x4 lf0 = {0.f, 0.f, 0.f, 0.f}, lf1 = {0.f, 0.f, 0.f, 0.f}; v4u q8 = {0u, 0u, 0u, 0u}, v8 = {0u, 0u, 0u, 0u};
        if (c < nvalid) { const size_t e = (size_t)(t0 + c) * DA + h * 128 + 8 * kg;
            lf0 = NTL((const GAS f32x4*)(LFg + e)); lf1 = NTL((const GAS f32x4*)(LFg + e + 4)); q8 = NTL((const GAS v4u*)(Qg + e)); v8 = NTL((const GAS v4u*)(Vg + e)); }
        VM_WAIT();
        *(LAS f32x4*)(LB + c * 132 + 8 * kg) = lf0; *(LAS f32x4*)(LB + c * 132 + 8 * kg + 4) = lf1;
        { const unsigned vv[4] = {v8.x, v8.y, v8.z, v8.w};
#pragma unroll
          for (int j = 0; j < 4; ++j) { VT[(8 * kg + 2 * j) * 40 + c] = (bf16)(vv[j] & 0xffffu); VT[(8 * kg + 2 * j + 1) * 40 + c] = (bf16)(vv[j] >> 16); } }
        LDSBAR();
        if (tid < 128) { float run = 0.f;
#pragma unroll 8
            for (int cc = 0; cc < 32; ++cc) { run += LB[cc * 132 + tid]; LB[cc * 132 + tid] = run; } }
        LDSBAR();
        {
            const f32x4 b0 = *(LAS f32x4*)(LB + c * 132 + 8 * kg), b1 = *(LAS f32x4*)(LB + c * 132 + 8 * kg + 4);
            const f32x4 e0 = *(LAS f32x4*)(LB + 31 * 132 + 8 * kg), e1 = *(LAS f32x4*)(LB + 31 * 132 + 8 * kg + 4);
            const unsigned qq[4] = {q8.x, q8.y, q8.z, q8.w};
            float qd[8], kd[8], ke[8];
#pragma unroll
            for (int j = 0; j < 8; ++j) { const float lfj = j < 4 ? lf0[j] : lf1[j - 4], bj = j < 4 ? b0[j] : b1[j - 4], blj = j < 4 ? e0[j] : e1[j - 4];
                const float qj = (j & 1) ? bfhi(qq[j >> 1]) : bflo(qq[j >> 1]);
                const float kin = 1.0f - __expf(lfj);
                qd[j] = qj * __expf(bj); kd[j] = kin * __expf(-bj); ke[j] = kin * __expf(blj - bj); }
            v4u w; w.x = pk2(qd[0], qd[1]); w.y = pk2(qd[2], qd[3]); w.z = pk2(qd[4], qd[5]); w.w = pk2(qd[6], qd[7]);
            *(LAS v4u*)(QD + c * 136 + 8 * kg) = w;
            v4u wk; wk.x = pk2(kd[0], kd[1]); wk.y = pk2(kd[2], kd[3]); wk.z = pk2(kd[4], kd[5]); wk.w = pk2(kd[6], kd[7]);
            *(LAS v4u*)(KD + c * 136 + 8 * kg) = wk;
#pragma unroll
            for (int j = 0; j < 8; ++j) KET[(8 * kg + j) * 40 + c] = (bf16)f2bf(ke[j]);
#pragma unroll
            for (int g = 0; g < 2; ++g) { const int g4 = 2 * kg + g, m = g4 >> 3, r8 = g4 & 7, jh = r8 >> 2, q4 = r8 & 3, ch = c >> 4, lp_ = 16 * q4 + (c & 15);
                const int o = (((ch * 4 + m) * 64 + lp_) << 4) + jh * 8;
                v2u x; x.x = g ? w.z : w.x; x.y = g ? w.w : w.y;
                *(GAS v2u*)(qf + (size_t)(o >> 8) * qp + (o & 255)) = x; }
            if (c == 0) { const int o = 10240 + 32 * kg; unsigned char* p = lf + (size_t)(o >> 9) * lp + (o & 511);
                f32x4 d0, d1;
#pragma unroll
                for (int j = 0; j < 4; ++j) { d0[j] = __expf(e0[j]); d1[j] = __expf(e1[j]); }
                *(GAS f32x4*)p = d0; *(GAS f32x4*)(p + 16) = d1; }
        }
        LDSBAR();
        if (wave < 4) {
            const int cb = wave >> 1, sb = wave & 1, r = lane & 15, q = lane >> 4;
            f32x4 a4 = {0.f, 0.f, 0.f, 0.f};
            if (!(cb == 0 && sb == 1)) {
#pragma unroll
                for (int kk = 0; kk < 4; ++kk) { const bf16x8 a = *(LAS bf16x8*)(QD + (16 * cb + r) * 136 + 32 * kk + 8 * q), bb = *(LAS bf16x8*)(KD + (16 * sb + r) * 136 + 32 * kk + 8 * q);
                    a4 = __builtin_amdgcn_mfma_f32_16x16x32_bf16(a, bb, a4, 0, 0, 0); }
            }
#pragma unroll
            for (int i = 0; i < 4; ++i) { const int cc = 16 * cb + 4 * q + i, ss = 16 * sb + r; SC[cc * 40 + ss] = (bf16)f2bf(cc >= ss ? a4[i] : 0.f); }
        } else {
            const int tt = tid - 256;
#pragma unroll
            for (int rep = 0; rep < 2; ++rep) { const int p = tt + 256 * rep, kb = p >> 6, l2 = p & 63, o = p << 4;
                const v4u x = *(LAS v4u*)(KET + (16 * kb + (l2 & 15)) * 40 + 8 * (l2 >> 4));
                *(GAS v4u*)(lf + (size_t)(o >> 9) * lp + (o & 511)) = x;
                const v4u y = *(LAS v4u*)(VT + (16 * kb + (l2 & 15)) * 40 + 8 * (l2 >> 4));
                *(GAS v4u*)(vf + (size_t)(o >> 8) * qp + (o & 255)) = y; }
        }
        LDSBAR();
        if (tid < 128) { const int p = tid, ch = p >> 6, l2 = p & 63, o = 8192 + (p << 4);
            const v4u x = *(LAS v4u*)(SC + (16 * ch + (l2 & 15)) * 40 + 8 * (l2 >> 4));
            *(GAS v4u*)(lf + (size_t)(o >> 9) * lp + (o & 511)) = x; }
        LDSBAR();
    }
}

struct HgPre { v4u q, v, l0, l1; };
constexpr int HG_SLOT = 27648;
__device__ __forceinline__ void hg_chunk(const LAS unsigned char* sl, f32x4 (&S)[8], float* Orow, int nvalid, int vs, int lane) {
    const int r = lane & 15, q = lane >> 4;
    const bf16x8 vfr = *(const LAS bf16x8*)(sl + 16384 + ((vs * 64 + lane) << 4));
    f32x4 o0 = {0.f, 0.f, 0.f, 0.f}, o1 = {0.f, 0.f, 0.f, 0.f};
    { const bf16x8 s0 = *(const LAS bf16x8*)(sl + 24576 + (lane << 4)), s1 = *(const LAS bf16x8*)(sl + 24576 + ((64 + lane) << 4));
      o0 = __builtin_amdgcn_mfma_f32_16x16x32_bf16(s0, vfr, o0, 0, 0, 0); o1 = __builtin_amdgcn_mfma_f32_16x16x32_bf16(s1, vfr, o1, 0, 0, 0); }
#pragma unroll
    for (int m = 0; m < 4; ++m) {
        v4u sw; sw.x = pk2(S[2 * m][0], S[2 * m][1]); sw.y = pk2(S[2 * m][2], S[2 * m][3]); sw.z = pk2(S[2 * m + 1][0], S[2 * m + 1][1]); sw.w = pk2(S[2 * m + 1][2], S[2 * m + 1][3]);
        const bf16x8 sb = __builtin_bit_cast(bf16x8, sw);
        const bf16x8 a0 = *(const LAS bf16x8*)(sl + ((m * 64 + lane) << 4)), a1 = *(const LAS bf16x8*)(sl + (((4 + m) * 64 + lane) << 4));
        o0 = __builtin_amdgcn_mfma_f32_16x16x32_bf16(a0, sb, o0, 0, 0, 0); o1 = __builtin_amdgcn_mfma_f32_16x16x32_bf16(a1, sb, o1, 0, 0, 0);
    }
#pragma unroll
    for (int i = 0; i < 4; ++i) { const int c0 = 4 * q + i;
        if (c0 < nvalid) Orow[(size_t)c0 * DA + 16 * vs + r] = o0[i];
        if (c0 + 16 < nvalid) Orow[(size_t)(c0 + 16) * DA + 16 * vs + r] = o1[i]; }
#pragma unroll
    for (int kb = 0; kb < 8; ++kb) { const f32x4 d = *(const LAS f32x4*)(sl + 26624 + ((16 * kb + 4 * q) << 2));
        const bf16x8 ke = *(const LAS bf16x8*)(sl + 8192 + ((kb * 64 + lane) << 4));
        S[kb] = __builtin_amdgcn_mfma_f32_16x16x32_bf16(ke, vfr, S[kb] * d, 0, 0, 0); }
}
__device__ __forceinline__ void hg_seq(const Frame& F, unsigned char* ws, const float* s0, float* sout, float* Og, int seq, bool sample, int vs_base, int nvs) {
    LAS unsigned char* ring = F.lds;
    const int tid = F.tid, lane = F.lane, vs = vs_base + F.wave, r = lane & 15, q = lane >> 4;
    const bool active = F.wave < nvs, vload = (unsigned)((tid >> 6) - vs_base) < (unsigned)nvs;
    int nch, nvalid, t0, h; const unsigned char *qf, *vf, *lf; int qp, lp; size_t qstep, lstep;
    if (!sample) { const int b = seq >> 2; h = seq & 3; t0 = b * 2048; nch = 64; nvalid = 32; const size_t e0 = (size_t)t0 * DA + h * 128;
        qf = ws + WS_Q + e0 * 2; vf = ws + WS_V + e0 * 2; lf = ws + WS_LOGF + e0 * 4; qp = 1024; lp = 2048; qstep = 32 * 1024; lstep = 32 * 2048; }
    else { const int b = seq >> 2; h = seq & 3; t0 = TP + b * 8; nch = 1; nvalid = 8; const unsigned char* base = (const unsigned char*)sout + (size_t)seq * 65536;
        qf = base; vf = base + 8192; lf = base + 16384; qp = 256; lp = 512; qstep = 0; lstep = 0; }
    const size_t offq = (size_t)(tid >> 4) * qp + (tid & 15) * 16, offl0 = (size_t)(tid >> 5) * lp + (tid & 31) * 16, offl1 = (size_t)(16 + (tid >> 5)) * lp + (tid & 31) * 16, offl1c = tid < 160 ? offl1 : offl0;
    {
    f32x4 S[8];
    if (sample && active) {
#pragma unroll
        for (int kb = 0; kb < 8; ++kb)
#pragma unroll
            for (int i = 0; i < 4; ++i) S[kb][i] = s0[((size_t)seq * 128 + 16 * kb + 4 * q + i) * 128 + 16 * vs + r];
    } else {
#pragma unroll
        for (int kb = 0; kb < 8; ++kb) S[kb] = (f32x4){0.f, 0.f, 0.f, 0.f};
    }
    float* Ob = Og + (size_t)t0 * DA + h * 128;
#define HG_LOAD(R, n) do { if (sample) { if ((n) < nch) { R.q = NTL((const GAS v4u*)(qf + offq)); if (vload) R.v = NTL((const GAS v4u*)(vf + offq)); R.l0 = NTL((const GAS v4u*)(lf + offl0)); if (tid < 160) R.l1 = NTL((const GAS v4u*)(lf + offl1)); } } \
        else { const int n_ = (n) < nch ? (n) : nch - 1; const unsigned char* q_ = qf + (size_t)n_ * qstep; const unsigned char* v_ = vf + (size_t)n_ * qstep; const unsigned char* l_ = lf + (size_t)n_ * lstep; \
        R.q = NTL((const GAS v4u*)(q_ + offq)); R.v = NTL((const GAS v4u*)(v_ + offq)); R.l0 = NTL((const GAS v4u*)(l_ + offl0)); R.l1 = NTL((const GAS v4u*)(l_ + offl1c)); } } while (0)
#define HG_STORE(R, s) do { LAS unsigned char* d_ = ring + (s) * HG_SLOT; *(LAS v4u*)(d_ + 16 * tid) = R.q; if (vload) *(LAS v4u*)(d_ + 16384 + 16 * tid) = R.v; *(LAS v4u*)(d_ + 8192 + 16 * tid) = R.l0; \
        if (tid < 160) *(LAS v4u*)(d_ + 24576 + 16 * tid) = R.l1; } while (0)
    HgPre R0, R1, R2, R3, R4, R5;
    R0.l1 = R0.v = (v4u){0u, 0u, 0u, 0u}; R1.l1 = R1.v = (v4u){0u, 0u, 0u, 0u}; R2.l1 = R2.v = (v4u){0u, 0u, 0u, 0u}; R3.l1 = R3.v = (v4u){0u, 0u, 0u, 0u}; R4.l1 = R4.v = (v4u){0u, 0u, 0u, 0u}; R5.l1 = R5.v = (v4u){0u, 0u, 0u, 0u};
    HG_LOAD(R0, 0); HG_LOAD(R1, 1); HG_LOAD(R2, 2); HG_LOAD(R3, 3); HG_LOAD(R4, 4);
    HG_STORE(R0, 0); LDSBAR();
    for (int n = 0; n < nch; n += 6) {
        HG_LOAD(R5, n + 5); if (active) hg_chunk(ring, S, Ob + (size_t)(n + 0) * 32 * DA, nvalid, vs, lane); if (n + 1 < nch) HG_STORE(R1, 1); LDSBAR(); if (n + 1 >= nch) break;
        HG_LOAD(R0, n + 6); if (active) hg_chunk(ring + HG_SLOT, S, Ob + (size_t)(n + 1) * 32 * DA, nvalid, vs, lane); if (n + 2 < nch) HG_STORE(R2, 0); LDSBAR(); if (n + 2 >= nch) break;
        HG_LOAD(R1, n + 7); if (active) hg_chunk(ring, S, Ob + (size_t)(n + 2) * 32 * DA, nvalid, vs, lane); if (n + 3 < nch) HG_STORE(R3, 1); LDSBAR(); if (n + 3 >= nch) break;
        HG_LOAD(R2, n + 8); if (active) hg_chunk(ring + HG_SLOT, S, Ob + (size_t)(n + 3) * 32 * DA, nvalid, vs, lane); if (n + 4 < nch) HG_STORE(R4, 0); LDSBAR(); if (n + 4 >= nch) break;
        HG_LOAD(R3, n + 9); if (active) hg_chunk(ring, S, Ob + (size_t)(n + 4) * 32 * DA, nvalid, vs, lane); if (n + 5 < nch) HG_STORE(R5, 1); LDSBAR(); if (n + 5 >= nch) break;
        HG_LOAD(R4, n + 10); if (active) hg_chunk(ring + HG_SLOT, S, Ob + (size_t)(n + 5) * 32 * DA, nvalid, vs, lane); if (n + 6 < nch) HG_STORE(R0, 0); LDSBAR();
    }
    if (active) {
#pragma unroll
    for (int kb = 0; kb < 8; ++kb)
#pragma unroll
        for (int i = 0; i < 4; ++i) sout[((size_t)seq * 128 + 16 * kb + 4 * q + i) * 128 + 16 * vs + r] = S[kb][i];
    }
    LDSBAR();
    }
}


#undef HG_LOAD
#undef HG_STORE
struct SgPre { v4u a0, a1, b0, b1; };
template <class Epi>
__device__ __forceinline__ void small_gemm(const Frame& F, const bf16* A, const bf16* Bt, int row_base, int K, const Epi E) {
    constexpr int LDT = 136, BUF = 64 * LDT;
    LAS bf16* As = (LAS bf16*)F.lds; LAS bf16* Bs = As + 2 * BUF;
    const int tid = F.tid, lane = F.lane, w = F.wave, r = lane & 15, q = lane >> 4, prow = tid >> 3, pk = (tid & 7) * 8, ns = K / 128;
    for (int u = F.vcu; u < 256; u += F.G) {
        const int r0 = row_base + (u >> 4) * 64, c0 = (u & 15) * 64;
        const bf16* ap = A + (size_t)(r0 + prow) * K + pk; const bf16* bp = Bt + (size_t)(c0 + prow) * K + pk;
        f32x4 acc0 = {0.f, 0.f, 0.f, 0.f}, acc1 = {0.f, 0.f, 0.f, 0.f};
        const typename Epi::Pre ep0 = E.pre4(r0 + 16 * (w & 3) + r, c0 + 32 * (w >> 2) + 4 * q), ep1 = E.pre4(r0 + 16 * (w & 3) + r, c0 + 32 * (w >> 2) + 16 + 4 * q);
#define SG_LOAD(R, s_) do { if ((s_) < ns) { R.a0 = NTL((const GAS v4u*)(ap + (s_) * 128)); R.a1 = NTL((const GAS v4u*)(ap + (s_) * 128 + 64)); R.b0 = NTL((const GAS v4u*)(bp + (s_) * 128)); R.b1 = NTL((const GAS v4u*)(bp + (s_) * 128 + 64)); } } while (0)
#define SG_STORE(R, b_) do { *(LAS v4u*)(As + (b_) * BUF + prow * LDT + pk) = R.a0; *(LAS v4u*)(As + (b_) * BUF + prow * LDT + pk + 64) = R.a1; *(LAS v4u*)(Bs + (b_) * BUF + prow * LDT + pk) = R.b0; *(LAS v4u*)(Bs + (b_) * BUF + prow * LDT + pk + 64) = R.b1; } while (0)
#define SG_COMP(b_) do { _Pragma("unroll") for (int kk = 0; kk < 4; ++kk) { \
            const bf16x8 a_ = *(const LAS bf16x8*)(As + (b_) * BUF + (16 * (w & 3) + r) * LDT + 32 * kk + 8 * q); \
            const bf16x8 x0_ = *(const LAS bf16x8*)(Bs + (b_) * BUF + (32 * (w >> 2) + r) * LDT + 32 * kk + 8 * q), x1_ = *(const LAS bf16x8*)(Bs + (b_) * BUF + (32 * (w >> 2) + 16 + r) * LDT + 32 * kk + 8 * q); \
            acc0 = __builtin_amdgcn_mfma_f32_16x16x32_bf16(x0_, a_, acc0, 0, 0, 0); acc1 = __builtin_amdgcn_mfma_f32_16x16x32_bf16(x1_, a_, acc1, 0, 0, 0); } } while (0)
        SgPre R0, R1, R2, R3;
        SG_LOAD(R0, 0); SG_LOAD(R1, 1); SG_LOAD(R2, 2);
        SG_STORE(R0, 0); LDSBAR();
        for (int s = 0; s < ns; s += 4) {
            SG_LOAD(R3, s + 3); SG_COMP(0); if (s + 1 < ns) SG_STORE(R1, 1); LDSBAR(); if (s + 1 >= ns) break;
            SG_LOAD(R0, s + 4); SG_COMP(1); if (s + 2 < ns) SG_STORE(R2, 0); LDSBAR(); if (s + 2 >= ns) break;
            SG_LOAD(R1, s + 5); SG_COMP(0); if (s + 3 < ns) SG_STORE(R3, 1); LDSBAR(); if (s + 3 >= ns) break;
            SG_LOAD(R2, s + 6); SG_COMP(1); if (s + 4 < ns) SG_STORE(R0, 0); LDSBAR();
        }
#undef SG_LOAD
#undef SG_STORE
#undef SG_COMP
        { float ss = E.store4p(r0 + 16 * (w & 3) + r, c0 + 32 * (w >> 2) + 4 * q, acc0, ep0);
          ss += E.store4p(r0 + 16 * (w & 3) + r, c0 + 32 * (w >> 2) + 16 + 4 * q, acc1, ep1);
          if (E.has_norm()) {
              LAS float* RS_ = (LAS float*)F.lds;
              ss += __shfl_xor(ss, 16); ss += __shfl_xor(ss, 32);
              if (q == 0) RS_[(w >> 2) * 64 + 16 * (w & 3) + r] = ss;
              LDSBAR();
              if (tid < 64) E.row_store_s(r0 + tid, u & 15, RS_[tid] + RS_[64 + tid]);
              LDSBAR(); } }
    }
}


__device__ __forceinline__ void small_gemm_dual(const Frame& F, const bf16* ZA, const bf16* WA, const bf16* ZB, const bf16* WB, const bf16* SGA, const bf16* SGB, bf16* MG, int row_base) {
    constexpr int K = DA, LDT = 72, ARR = 64 * LDT, BUF = 4 * ARR, ns = K / 64;
    LAS bf16* L = (LAS bf16*)F.lds;
    const int tid = F.tid, lane = F.lane, w = F.wave, r = lane & 15, q = lane >> 4, prow = tid >> 3, pk = (tid & 7) * 8;
    for (int u = F.vcu; u < 256; u += F.G) {
        const int r0 = row_base + (u >> 4) * 64, c0 = (u & 15) * 64;
        const bf16* a1p = ZA + (size_t)(r0 + prow) * K + pk; const bf16* b1p = WA + (size_t)(c0 + prow) * K + pk;
        const bf16* a2p = ZB + (size_t)(r0 + prow) * K + pk; const bf16* b2p = WB + (size_t)(c0 + prow) * K + pk;
        const int orow = r0 + 16 * (w & 3) + r, ocol = c0 + 32 * (w >> 2) + 4 * q;
        const size_t o0 = (size_t)orow * DM + ocol, o1 = o0 + 16;
        const v2u ga0 = NTL((const GAS v2u*)(SGA + o0)), ga1 = NTL((const GAS v2u*)(SGA + o1)), gb0 = NTL((const GAS v2u*)(SGB + o0)), gb1 = NTL((const GAS v2u*)(SGB + o1));
        f32x4 aa0 = {0.f, 0.f, 0.f, 0.f}, aa1 = aa0, ab0 = aa0, ab1 = aa0;
#define SD_LOAD(R, s_) do { const int c_ = (s_) < ns ? (s_) : ns - 1; R.a0 = NTL((const GAS v4u*)(a1p + c_ * 64)); R.a1 = NTL((const GAS v4u*)(b1p + c_ * 64)); R.b0 = NTL((const GAS v4u*)(a2p + c_ * 64)); R.b1 = NTL((const GAS v4u*)(b2p + c_ * 64)); } while (0)
#define SD_STORE(R, b_) do { LAS bf16* d_ = L + (b_) * BUF + prow * LDT + pk; *(LAS v4u*)(d_) = R.a0; *(LAS v4u*)(d_ + ARR) = R.a1; *(LAS v4u*)(d_ + 2 * ARR) = R.b0; *(LAS v4u*)(d_ + 3 * ARR) = R.b1; } while (0)
#define SD_COMP(b_) do { const LAS bf16* s_ = L + (b_) * BUF; _Pragma("unroll") for (int kk = 0; kk < 2; ++kk) { const int ko_ = 32 * kk + 8 * q; \
            const bf16x8 a1_ = *(const LAS bf16x8*)(s_ + (16 * (w & 3) + r) * LDT + ko_), a2_ = *(const LAS bf16x8*)(s_ + 2 * ARR + (16 * (w & 3) + r) * LDT + ko_); \
            const bf16x8 x10_ = *(const LAS bf16x8*)(s_ + ARR + (32 * (w >> 2) + r) * LDT + ko_), x11_ = *(const LAS bf16x8*)(s_ + ARR + (32 * (w >> 2) + 16 + r) * LDT + ko_); \
            const bf16x8 x20_ = *(const LAS bf16x8*)(s_ + 3 * ARR + (32 * (w >> 2) + r) * LDT + ko_), x21_ = *(const LAS bf16x8*)(s_ + 3 * ARR + (32 * (w >> 2) + 16 + r) * LDT + ko_); \
            aa0 = __builtin_amdgcn_mfma_f32_16x16x32_bf16(x10_, a1_, aa0, 0, 0, 0); aa1 = __builtin_amdgcn_mfma_f32_16x16x32_bf16(x11_, a1_, aa1, 0, 0, 0); \
            ab0 = __builtin_amdgcn_mfma_f32_16x16x32_bf16(x20_, a2_, ab0, 0, 0, 0); ab1 = __builtin_amdgcn_mfma_f32_16x16x32_bf16(x21_, a2_, ab1, 0, 0, 0); } } while (0)
        SgPre R0, R1, R2, R3;
        SD_LOAD(R0, 0); SD_LOAD(R1, 1); SD_LOAD(R2, 2);
        SD_STORE(R0, 0); LDSBAR();
        for (int s = 0; s < ns; s += 4) {
            SD_LOAD(R3, s + 3); SD_COMP(0); if (s + 1 < ns) SD_STORE(R1, 1); LDSBAR(); if (s + 1 >= ns) break;
            SD_LOAD(R0, s + 4); SD_COMP(1); if (s + 2 < ns) SD_STORE(R2, 0); LDSBAR(); if (s + 2 >= ns) break;
            SD_LOAD(R1, s + 5); SD_COMP(0); if (s + 3 < ns) SD_STORE(R3, 1); LDSBAR(); if (s + 3 >= ns) break;
            SD_LOAD(R2, s + 6); SD_COMP(1); if (s + 4 < ns) SD_STORE(R0, 0); LDSBAR();
        }
#undef SD_LOAD
#undef SD_STORE
#undef SD_COMP
        { v2u w0; w0.x = pk2(bflo(ga0.x) * aa0[0] + bflo(gb0.x) * ab0[0], bfhi(ga0.x) * aa0[1] + bfhi(gb0.x) * ab0[1]); w0.y = pk2(bflo(ga0.y) * aa0[2] + bflo(gb0.y) * ab0[2], bfhi(ga0.y) * aa0[3] + bfhi(gb0.y) * ab0[3]);
          *(GAS v2u*)(MG + o0) = w0;
          v2u w1; w1.x = pk2(bflo(ga1.x) * aa1[0] + bflo(gb1.x) * ab1[0], bfhi(ga1.x) * aa1[1] + bfhi(gb1.x) * ab1[1]); w1.y = pk2(bflo(ga1.y) * aa1[2] + bflo(gb1.y) * ab1[2], bfhi(ga1.y) * aa1[3] + bfhi(gb1.y) * ab1[3]);
          *(GAS v2u*)(MG + o1) = w1; }
    }
}

__device__ __forceinline__ void zb_rows(unsigned char* ws, const float* cw, const float* st_c, float* out, int lane, int gw, int NGW) {
    bf16* BGb = (bf16*)(ws + WS_BG); const bf16* Ub = (const bf16*)(ws + WS_U);
    const int hl = lane & 31, hw = lane >> 5, c0 = 16 * hl;
    for (int t = 2 * gw + hw; t < T; t += 2 * NGW) {
        const bool smp = t >= TP; const int pos = smp ? ((t - TP) & 7) : (t & 2047), L = smp ? 8 : 2048, bb = smp ? ((t - TP) >> 3) : (t >> 11);
        const size_t e = (size_t)t * DA + c0;
        v4u bg[2], u0[2], x1[2], x2[2];
#pragma unroll
        for (int h = 0; h < 2; ++h) { bg[h] = NTL((const GAS v4u*)(BGb + e + 8 * h)); u0[h] = NTL((const GAS v4u*)(Ub + e + 8 * h));
            x1[h] = (pos >= 1) ? NTL((const GAS v4u*)(Ub + e - DA + 8 * h)) : (v4u){0u, 0u, 0u, 0u};
            x2[h] = (pos >= 2) ? NTL((const GAS v4u*)(Ub + e - 2 * DA + 8 * h)) : (v4u){0u, 0u, 0u, 0u}; }
#pragma unroll
        for (int h = 0; h < 2; ++h) {
            float um1[8], um2[8];
            { const v4u x = x1[h]; um1[0] = bflo(x.x); um1[1] = bfhi(x.x); um1[2] = bflo(x.y); um1[3] = bfhi(x.y); um1[4] = bflo(x.z); um1[5] = bfhi(x.z); um1[6] = bflo(x.w); um1[7] = bfhi(x.w); }
            { const v4u x = x2[h]; um2[0] = bflo(x.x); um2[1] = bfhi(x.x); um2[2] = bflo(x.y); um2[3] = bfhi(x.y); um2[4] = bflo(x.z); um2[5] = bfhi(x.z); um2[6] = bflo(x.w); um2[7] = bfhi(x.w); }
            if (smp && pos < 1) { const size_t so = ((size_t)bb * 2 + 1) * DA + c0 + 8 * h; const f32x4 a = *(const GAS f32x4*)(st_c + so), b = *(const GAS f32x4*)(st_c + so + 4);
                um1[0] = a.x; um1[1] = a.y; um1[2] = a.z; um1[3] = a.w; um1[4] = b.x; um1[5] = b.y; um1[6] = b.z; um1[7] = b.w; }
            if (smp && pos < 2) { const size_t so = ((size_t)bb * 2 + pos) * DA + c0 + 8 * h; const f32x4 a = *(const GAS f32x4*)(st_c + so), b = *(const GAS f32x4*)(st_c + so + 4);
                um2[0] = a.x; um2[1] = a.y; um2[2] = a.z; um2[3] = a.w; um2[4] = b.x; um2[5] = b.y; um2[6] = b.z; um2[7] = b.w; }
            const unsigned uw[4] = {u0[h].x, u0[h].y, u0[h].z, u0[h].w}, bw[4] = {bg[h].x, bg[h].y, bg[h].z, bg[h].w};
            const f32x4 w0a = *(const GAS f32x4*)(cw + c0 + 8 * h), w0b = *(const GAS f32x4*)(cw + c0 + 8 * h + 4), w1a = *(const GAS f32x4*)(cw + DA + c0 + 8 * h), w1b = *(const GAS f32x4*)(cw + DA + c0 + 8 * h + 4),
                        w2a = *(const GAS f32x4*)(cw + 2 * DA + c0 + 8 * h), w2b = *(const GAS f32x4*)(cw + 2 * DA + c0 + 8 * h + 4);
            float zb[8], uf[8];
#pragma unroll
            for (int j = 0; j < 8; ++j) { uf[j] = (j & 1) ? bfhi(uw[j >> 1]) : bflo(uw[j >> 1]); const float bgj = (j & 1) ? bfhi(bw[j >> 1]) : bflo(bw[j >> 1]);
                const float w0 = j < 4 ? w0a[j & 3] : w0b[j & 3], w1 = j < 4 ? w1a[j & 3] : w1b[j & 3], w2 = j < 4 ? w2a[j & 3] : w2b[j & 3];
                zb[j] = bgj * (w0 * um2[j] + w1 * um1[j] + w2 * uf[j]); }
            v4u zw; zw.x = pk2(zb[0], zb[1]); zw.y = pk2(zb[2], zb[3]); zw.z = pk2(zb[4], zb[5]); zw.w = pk2(zb[6], zb[7]);
            *(GAS v4u*)(BGb + e + 8 * h) = zw;
            if (pos >= L - 2) { float* so = out + (smp ? OUT_SCS : OUT_SCP) + ((size_t)bb * 2 + (pos - (L - 2))) * DA + c0 + 8 * h;
                *(GAS f32x4*)so = (f32x4){uf[0], uf[1], uf[2], uf[3]}; *(GAS f32x4*)(so + 4) = (f32x4){uf[4], uf[5], uf[6], uf[7]}; }
        }
    }
}


__device__ __forceinline__ int unit_pm_n5632(int L) { const int wgid = (L % 8) * 187 + L / 8, gid = wgid / 176, fm = gid * 8, gsz = (68 - fm) < 8 ? (68 - fm) : 8; return fm + ((wgid % 176) % gsz); }
__device__ __forceinline__ void rstd_prefetch(const Frame& F, const float* PP, const float* PS) {
    LAS int* PMT = (LAS int*)(F.lds + PMT_OFF); LAS float* RSL = (LAS float*)(F.lds + RSL_OFF);
    for (int i = 0; i < RSL_SLOTS; ++i) { const int L = i * F.G + (int)blockIdx.x; const bool ok = (L < 1496) && (F.G % 8 == 0);
        const int pm = ok ? unit_pm_n5632(L) : -1;
        if (ok && F.tid < 256) RSL[i * 256 + F.tid] = pg8::row_rstd(PP, PS, pm * 256 + F.tid);
        if (F.tid == 0) PMT[i] = pm; }
    __syncthreads();
}

__global__ void __launch_bounds__(NWAVES * 64, 2) mk_fwd(Args args) {
    extern __shared__ __attribute__((aligned(16))) unsigned char lds[];
    Frame F;
    F.lds = (LAS unsigned char*)lds;
    F.MISC = (volatile LAS unsigned*)(F.lds + MISC_OFF);
    F.tid = threadIdx.x; F.lane = F.tid & 63; F.wave = __builtin_amdgcn_readfirstlane(F.tid >> 6);
    F.G = gridDim.x; { const int bx = blockIdx.x; F.vcu = (F.G % 8 == 0) ? (bx % 8) * (F.G / 8) + bx / 8 : bx; }
    unsigned char* ws = args.ws;
    F.ctl = (gu32*)(ws + WS_CTL);
    for (int u = F.tid; u < (LDS_BYTES - LDSCTL_OFF) / 4; u += NWAVES * 64) ((LAS unsigned*)(F.lds + LDSCTL_OFF))[u] = 0u;
    __syncthreads();
    XcdBarrier bar = xcd_barrier_post((unsigned*)(F.ctl + CW_BAR), F.MISC + 8);
#define GRID_BAR() do { xcd_barrier(bar); REFRESH(); } while (0)
    float* out = args.out;
    bf16* XN = (bf16*)(ws + WS_XN); bf16* Hb = (bf16*)(ws + WS_H);
    const int NGW = F.G * NWAVES;
    const unsigned phmask = args.mask;
    const int first_idle = 1496 % F.G, n_idle = first_idle ? F.G - first_idle : F.G, my_idle = first_idle ? (int)blockIdx.x - first_idle : (int)blockIdx.x;
    const int INGW = n_idle * NWAVES;
#define IGW_ (my_idle * NWAVES + F.wave)
#if defined(PROBE_F) || defined(PROBE_G)
    int probe_two = 2; asm volatile("" : "+s"(probe_two));
#endif
#define GW_ (F.vcu * NWAVES + F.wave)
#define PARTP_ ((float*)(ws + WS_PARTP))
#define PARTS_ ((float*)(ws + WS_PARTS))
#define SCR_ ((LAS float*)(F.lds + F.wave * 16384))
#define REFRESH() do { int t_ = threadIdx.x; asm volatile("" : "+v"(t_)); F.tid = t_; F.lane = t_ & 63; F.wave = __builtin_amdgcn_readfirstlane(t_ >> 6); } while (0)

    if (phmask & (1u << 0)) {
#ifdef PROBE_C
    for (int rep_ = 0; rep_ < 3; ++rep_)
#endif
    {
        conv_w13(kin(6), kin(7), nullptr, ws, SCR_, F.lane, GW_, NGW);
        conv_w2(kin(8), ws, SCR_, F.lane, (GW_ + NGW / 4) % NGW, NGW);
        { const float* win = kin(10); bf16* WIN = (bf16*)(ws + WS_WIN);
          conv_mat(win, nullptr, NIN, DM, 2560, WIN, 0, 0, SCR_, F.lane, (GW_ + NGW / 2) % NGW, NGW);
          conv_mat(win + 2560, nullptr, NIN, DM, 512, WIN, 1, 2560, SCR_, F.lane, (GW_ + NGW / 8) % NGW, NGW);
          conv_mat(win + 3072, nullptr, NIN, DM, 512, WIN, 1, 2560 + 16, SCR_, F.lane, (GW_ + 3 * (NGW / 8)) % NGW, NGW);
          conv_mat(win + 3584, nullptr, NIN, DM, 2048, WIN, 0, 3584, SCR_, F.lane, (GW_ + 3 * (NGW / 4)) % NGW, NGW); }
        { const float* xp = kin(0); const float* xs = kin(1); const float* g1 = kin(5);
          for (int m = 2 * GW_; m < T; m += 2 * NGW) { const float* ra = m < TP ? xp + (size_t)m * DM : xs + (size_t)(m - TP) * DM;
              rms_row2_bf16(ra, ra + DM, g1, XN + (size_t)m * DM, XN + (size_t)(m + 1) * DM, F.lane); } }
    }
    GRID_BAR();
#ifdef PROBE_E
    for (int rep_ = 0; rep_ < 10; ++rep_) GRID_BAR();
#endif
#if defined(PROBE_E2) || defined(PROBE_E3) || defined(PROBE_E4) || defined(PROBE_E5)
    for (int rep_ = 0; rep_ < 10; ++rep_) xcd_barrier_probe(bar);
#endif
    }

    if (phmask & (1u << 1)) {
#ifdef PROBE_F
    _Pragma("clang loop unroll(disable)") for (int rep_ = 0; rep_ < probe_two; ++rep_)
#endif
    { pg8::Gemm g{XN, (const bf16*)(ws + WS_W13), T, 2 * DFF, DM}; pg8::StaticOrder S; S.init(T, 2 * DFF, F.G, (int)blockIdx.x);
      pg8::EpiSwiglu E{Hb, DFF, nullptr, nullptr, F.lds}; pg8::gemm_phase<pg8::EpiSwiglu, pg8::StaticOrder, true, true>(F.lds, g, S, E); }
    GRID_BAR();
    }

    if (phmask & (1u << 2)) {
#ifdef PROBE_G
    _Pragma("clang loop unroll(disable)") for (int rep_ = 0; rep_ < probe_two; ++rep_)
#endif
    { pg8::Gemm g{Hb, (const bf16*)(ws + WS_W2), TP, DM, DFF}; pg8::StaticOrder S; S.init(TP, DM, F.G, (int)blockIdx.x);
      pg8::EpiRes<true> E{kin(0), kin(1), out, XN, PARTP_, PARTS_, F.lds, kin(9)};
      if ((blockIdx.x >> 3) & 1) { small_gemm(F, Hb, (const bf16*)(ws + WS_W2), TP, DFF, pg8::EpiRes<true>{kin(0), kin(1), out, XN, PARTP_, PARTS_, F.lds, kin(9)}); REFRESH(); pg8::gemm_phase<pg8::EpiRes<true>, pg8::StaticOrder, true, true>(F.lds, g, S, E); }
      else { pg8::gemm_phase<pg8::EpiRes<true>, pg8::StaticOrder, true, true>(F.lds, g, S, E); REFRESH(); small_gemm(F, Hb, (const bf16*)(ws + WS_W2), TP, DFF, pg8::EpiRes<true>{kin(0), kin(1), out, XN, PARTP_, PARTS_, F.lds, kin(9)}); } }
    GRID_BAR();
    }

    if (phmask & (1u << 3)) {
    rstd_prefetch(F, PARTP_, PARTS_);
    { pg8::Gemm g{XN, (const bf16*)(ws + WS_WIN), T, NIN, DM}; pg8::StaticOrder S; S.init(T, NIN, F.G, (int)blockIdx.x);
      pg8::EpiMix E{(bf16*)(ws + WS_Q), (bf16*)(ws + WS_V), (bf16*)(ws + WS_OG), (bf16*)(ws + WS_BG), (bf16*)(ws + WS_U), (bf16*)(ws + WS_SGA), (bf16*)(ws + WS_SGB), (float*)(ws + WS_LOGF), kin(4), PARTP_, PARTS_, F.lds};
      pg8::gemm_phase<pg8::EpiMix, pg8::StaticOrder, true, true>(F.lds, g, S, E); }
    GRID_BAR();
    }

    if (phmask & (1u << 4)) {
    hg_prep(F, ws, (unsigned char*)(out + OUT_SHS));
    GRID_BAR();
    }

    if (phmask & (1u << 5)) {
    {
        float* Og = (float*)(ws + WS_XN); const float* st_h = kin(2); const float* st_c = kin(3);
        const int bid = (int)blockIdx.x, G = F.G;
        constexpr int NSCAN = 4 * NSEQ_P;
        if (G >= 2 * NSCAN) {
            if (bid < NSCAN) { hg_seq(F, ws, st_h, out + OUT_SHS, Og, bid, true, 0, 8);
                               hg_seq(F, ws, nullptr, out + OUT_SHP, Og, bid >> 2, false, 2 * (bid & 3), 2); }
            else {
                for (int s = NSCAN + (bid - NSCAN); s < NSEQ_S; s += G - NSCAN) hg_seq(F, ws, st_h, out + OUT_SHS, Og, s, true, 0, 8);
                REFRESH();
                const int cgw = (bid - NSCAN) * NWAVES + F.wave, CNGW = (G - NSCAN) * NWAVES;
                zb_rows(ws, kin(11), st_c, out, F.lane, cgw, CNGW);
                conv_mat(kin(13), nullptr, DM, DA, DM, (bf16*)(ws + WS_WA), 0, 0, SCR_, F.lane, cgw, CNGW);
                conv_mat(kin(14), nullptr, DM, DA, DM, (bf16*)(ws + WS_WB), 0, 0, SCR_, F.lane, (cgw + CNGW / 4) % CNGW, CNGW);
                conv_mat(kin(15), nullptr, DM, DM, DM, (bf16*)(ws + WS_WO), 0, 0, SCR_, F.lane, (cgw + CNGW / 2) % CNGW, CNGW);
                conv_w13(kin(17), kin(18), nullptr, ws, SCR_, F.lane, cgw, CNGW);
                conv_w2(kin(19), ws, SCR_, F.lane, (cgw + CNGW / 3) % CNGW, CNGW);
            }
        } else {
            for (int s = bid; s < NSEQ_P; s += G) hg_seq(F, ws, nullptr, out + OUT_SHP, Og, s, false, 0, 8);
            for (int s = bid; s < NSEQ_S; s += G) hg_seq(F, ws, st_h, out + OUT_SHS, Og, s, true, 0, 8);
            REFRESH();
            zb_rows(ws, kin(11), st_c, out, F.lane, GW_, NGW);
            conv_mat(kin(13), nullptr, DM, DA, DM, (bf16*)(ws + WS_WA), 0, 0, SCR_, F.lane, GW_, NGW);
            conv_mat(kin(14), nullptr, DM, DA, DM, (bf16*)(ws + WS_WB), 0, 0, SCR_, F.lane, GW_, NGW);
            conv_mat(kin(15), nullptr, DM, DM, DM, (bf16*)(ws + WS_WO), 0, 0, SCR_, F.lane, GW_, NGW);
            conv_w13(kin(17), kin(18), nullptr, ws, SCR_, F.lane, GW_, NGW);
            conv_w2(kin(19), ws, SCR_, F.lane, GW_, NGW);
        }
    }
    GRID_BAR();
    }

    if (phmask & (1u << 6)) {
#ifdef PROBE_D
    for (int rep_ = 0; rep_ < 3; ++rep_)
#endif
    {
        const float* Og = (const float*)(ws + WS_XN); const bf16* OGb = (const bf16*)(ws + WS_OG); bf16* ZA = (bf16*)(ws + WS_ZA);
        const float* gh = kin(12);
        const int hl = F.lane & 31, hw = F.lane >> 5, c0 = 16 * hl;
        f32x4 gg[4];
#pragma unroll
        for (int j = 0; j < 4; ++j) gg[j] = *(const GAS f32x4*)(gh + c0 + 4 * j);
        for (int t = 2 * GW_ + hw; t < T; t += 2 * NGW) {
            const size_t e = (size_t)t * DA + c0;
            f32x4 o[4]; v4u og[2];
#pragma unroll
            for (int j = 0; j < 4; ++j) o[j] = NTL((const GAS f32x4*)(Og + e + 4 * j));
            og[0] = NTL((const GAS v4u*)(OGb + e)); og[1] = NTL((const GAS v4u*)(OGb + e + 8));
            float ss = 0.f;
#pragma unroll
            for (int j = 0; j < 4; ++j) ss += (o[j].x * o[j].x + o[j].y * o[j].y) + (o[j].z * o[j].z + o[j].w * o[j].w);
            ss += __shfl_xor(ss, 1); ss += __shfl_xor(ss, 2); ss += __shfl_xor(ss, 4);
            const float rstd = 1.f / sqrtf(ss * (1.f / 128.f) + EPS);
#pragma unroll
            for (int h = 0; h < 2; ++h) { const f32x4 a = o[2 * h] * rstd * gg[2 * h], b = o[2 * h + 1] * rstd * gg[2 * h + 1]; const v4u g8 = og[h];
                v4u za; za.x = pk2(a.x * bflo(g8.x), a.y * bfhi(g8.x)); za.y = pk2(a.z * bflo(g8.y), a.w * bfhi(g8.y)); za.z = pk2(b.x * bflo(g8.z), b.y * bfhi(g8.z)); za.w = pk2(b.z * bflo(g8.w), b.w * bfhi(g8.w));
                *(GAS v4u*)(ZA + e + 8 * h) = za; }
        }
    }
    GRID_BAR();
    }

    if (phmask & (1u << 7)) {
    {
      const bool small_first = ((blockIdx.x >> 3) & 1) != 0;
      if (small_first) { small_gemm_dual(F, (const bf16*)(ws + WS_ZA), (const bf16*)(ws + WS_WA), (const bf16*)(ws + WS_BG), (const bf16*)(ws + WS_WB), (const bf16*)(ws + WS_SGA), (const bf16*)(ws + WS_SGB), (bf16*)(ws + WS_MG), TP); REFRESH(); }
      { pg8::Gemm g{(const bf16*)(ws + WS_ZA), (const bf16*)(ws + WS_WA), TP, DM, DA}; pg8::StaticOrder S; S.init(TP, DM, F.G, (int)blockIdx.x);
        pg8::EpiGate<0> E{(const bf16*)(ws + WS_SGA), (bf16*)(ws + WS_MG)}; pg8::gemm_phase<pg8::EpiGate<0>, pg8::StaticOrder, true, true>(F.lds, g, S, E); }
      VM_WAIT();
      { pg8::Gemm g{(const bf16*)(ws + WS_BG), (const bf16*)(ws + WS_WB), TP, DM, DA}; pg8::StaticOrder S; S.init(TP, DM, F.G, (int)blockIdx.x);
        pg8::EpiGate<1> E{(const bf16*)(ws + WS_SGB), (bf16*)(ws + WS_MG)}; pg8::gemm_phase<pg8::EpiGate<1>, pg8::StaticOrder, true, true>(F.lds, g, S, E); }
      if (!small_first) { REFRESH(); small_gemm_dual(F, (const bf16*)(ws + WS_ZA), (const bf16*)(ws + WS_WA), (const bf16*)(ws + WS_BG), (const bf16*)(ws + WS_WB), (const bf16*)(ws + WS_SGA), (const bf16*)(ws + WS_SGB), (bf16*)(ws + WS_MG), TP); }
    }
    GRID_BAR();
    }

    if (phmask & (1u << 8)) {
    { pg8::Gemm g{(const bf16*)(ws + WS_MG), (const bf16*)(ws + WS_WO), TP, DM, DM}; pg8::StaticOrder S; S.init(TP, DM, F.G, (int)blockIdx.x);
      pg8::EpiRes<false> E{out, out + (size_t)TP * DM, out, XN, PARTP_, PARTS_, F.lds, kin(16)};
      if ((blockIdx.x >> 3) & 1) { small_gemm(F, (const bf16*)(ws + WS_MG), (const bf16*)(ws + WS_WO), TP, DM, pg8::EpiRes<false>{out, out + (size_t)TP * DM, out, XN, PARTP_, PARTS_, F.lds, kin(16)}); REFRESH(); pg8::gemm_phase<pg8::EpiRes<false>, pg8::StaticOrder, true, true>(F.lds, g, S, E); }
      else { pg8::gemm_phase<pg8::EpiRes<false>, pg8::StaticOrder, true, true>(F.lds, g, S, E); REFRESH(); small_gemm(F, (const bf16*)(ws + WS_MG), (const bf16*)(ws + WS_WO), TP, DM, pg8::EpiRes<false>{out, out + (size_t)TP * DM, out, XN, PARTP_, PARTS_, F.lds, kin(16)}); } }
    GRID_BAR();
    }

    if (phmask & (1u << 9)) {
    rstd_prefetch(F, PARTP_, PARTS_);
    { pg8::Gemm g{XN, (const bf16*)(ws + WS_W13), T, 2 * DFF, DM}; pg8::StaticOrder S; S.init(T, 2 * DFF, F.G, (int)blockIdx.x);
      pg8::EpiSwiglu E{Hb, DFF, PARTP_, PARTS_, F.lds}; pg8::gemm_phase<pg8::EpiSwiglu, pg8::StaticOrder, true, true>(F.lds, g, S, E); }
    GRID_BAR();
    { pg8::Gemm g{Hb, (const bf16*)(ws + WS_W2), TP, DM, DFF}; pg8::StaticOrder S; S.init(TP, DM, F.G, (int)blockIdx.x);
      pg8::EpiRes<true> E{out, out + (size_t)TP * DM, out, nullptr, nullptr, nullptr, F.lds, nullptr};
      if ((blockIdx.x >> 3) & 1) { small_gemm(F, Hb, (const bf16*)(ws + WS_W2), TP, DFF, pg8::EpiRes<true>{out, out + (size_t)TP * DM, out, nullptr, nullptr, nullptr, F.lds, nullptr}); REFRESH(); pg8::gemm_phase<pg8::EpiRes<true>, pg8::StaticOrder, true, true>(F.lds, g, S, E); }
      else { pg8::gemm_phase<pg8::EpiRes<true>, pg8::StaticOrder, true, true>(F.lds, g, S, E); REFRESH(); small_gemm(F, Hb, (const bf16*)(ws + WS_W2), TP, DFF, pg8::EpiRes<true>{out, out + (size_t)TP * DM, out, nullptr, nullptr, nullptr, F.lds, nullptr}); } }
    GRID_BAR();
    }

    if (phmask & (1u << 10)) {
    { const float* gg_ = kin(20); for (int m = 2 * GW_; m < T; m += 2 * NGW) rms_row2_f32(out + (size_t)m * DM, gg_, F.lane, m + 1 < T); }
    }
#undef GW_
#undef PARTP_
#undef PARTS_
#undef SCR_
#undef IGW_
#undef REFRESH
}

extern "C" void kernel_launch(void* const* d_in, const int* in_sizes, int n_in, void* d_out, int out_size, void* d_ws, size_t ws_size, hipStream_t stream) {
    static int grid = 0;
    if (grid == 0) {
        if (n_in != 21 || in_sizes[0] != TP * DM || (size_t)out_size != OUT_END || ws_size < WS_END) { fprintf(stderr, "kernel_launch: unexpected shapes (n_in %d, in0 %d, out %d, ws %zu)\n", n_in, n_in > 0 ? in_sizes[0] : -1, out_size, ws_size); grid = -1; return; }
        int dev = 0, cus = 0, per_cu = 0;
        if (hipGetDevice(&dev) != hipSuccess || hipDeviceGetAttribute(&cus, hipDeviceAttributeMultiprocessorCount, dev) != hipSuccess) { grid = -1; return; }
        if (hipFuncSetAttribute((const void*)mk_fwd, hipFuncAttributeMaxDynamicSharedMemorySize, LDS_BYTES) != hipSuccess) { fprintf(stderr, "kernel_launch: hipFuncSetAttribute failed\n"); grid = -1; return; }
        if (hipOccupancyMaxActiveBlocksPerMultiprocessor(&per_cu, (const void*)mk_fwd, NWAVES * 64, LDS_BYTES) != hipSuccess || per_cu < 1) { fprintf(stderr, "kernel_launch: occupancy query says %d blocks per CU\n", per_cu); }
        (void)hipGetLastError();
        grid = cus;
    }
    if (grid < 0) return;
    if (hipMemsetAsync((char*)d_ws + WS_CTL, 0, CTL_ZERO_BYTES, stream) != hipSuccess) return;
    Args a{};
    for (int i = 0; i < 21; ++i) a.in[i] = (const float*)d_in[i];
    a.out = (float*)d_out; a.ws = (unsigned char*)d_ws; a.mask = 0x0000ffffu; a.pad = 0u;
    hipLaunchKernelGGL(mk_fwd, dim3(grid), dim3(NWAVES * 64), LDS_BYTES, stream, a);
#ifdef PROBE_PHASE
    (void)hipMemsetAsync((char*)d_ws + WS_CTL, 0, CTL_ZERO_BYTES, stream);
    a.mask = (PROBE_PHASE);
    hipLaunchKernelGGL(mk_fwd, dim3(grid), dim3(NWAVES * 64), LDS_BYTES, stream, a);
#endif
}
```
